# Optimizing an MI355X kernel written in HIP

```python
import jax, jax.numpy as jnp
from jax import lax
import numpy as np

D_MODEL = 1024
BATCH = 8
SEQ = 4096
DEPTH = 1

ROPE_THETA = 500000.0
NORM_EPS = 1e-6
Q_BLOCK = 128

MLA_HEADS = 8
MLA_Q_RANK = 384
MLA_KV_RANK = 256
MLA_NOPE_DIM = 64
MLA_ROPE_DIM = 32
MLA_V_DIM = 64
MLA_WIDTH = MLA_HEADS * MLA_V_DIM

DIL_PATTERNS = ((128, 1), (512, 4), (2048, 16))
DIL_GROUPS = 3
DIL_HEADS_PER_GROUP = 8
DIL_HEADS = DIL_GROUPS * DIL_HEADS_PER_GROUP
DIL_HEAD_DIM = 64
DIL_ROPE_DIM = DIL_HEAD_DIM // 4
DIL_WIDTH = DIL_HEADS_PER_GROUP * DIL_HEAD_DIM

IN_SPLITS = (
    MLA_Q_RANK,
    MLA_KV_RANK,
    MLA_ROPE_DIM,
    3 * DIL_HEADS * DIL_HEAD_DIM,
    MLA_WIDTH,
    DIL_WIDTH,
    D_MODEL,
    D_MODEL,
)
IN_WIDTH = sum(IN_SPLITS)

kernel_name = "hybrid_mla_dilated_gated_parallel"


def rms_norm(x, g):
    xf = x.astype(jnp.float32)
    xf = xf * lax.rsqrt(jnp.mean(xf * xf, axis=-1, keepdims=True) + NORM_EPS)
    return (xf * g.astype(jnp.float32)).astype(x.dtype)


def rope_tables(positions, rot_dim):
    inv_freq = ROPE_THETA ** (-jnp.arange(0, rot_dim, 2, dtype=jnp.float32) / rot_dim)
    ang = positions.astype(jnp.float32)[..., None] * inv_freq
    return jnp.cos(ang), jnp.sin(ang)


def apply_rope(x, cos, sin):
    half = x.shape[-1] // 2
    xf = x.astype(jnp.float32)
    x1, x2 = xf[..., :half], xf[..., half:]
    return jnp.concatenate([x1 * cos - x2 * sin, x2 * cos + x1 * sin], axis=-1).astype(x.dtype)


def partial_rope(x, cos, sin, rot_dim):
    return jnp.concatenate([apply_rope(x[..., :rot_dim], cos, sin), x[..., rot_dim:]], axis=-1)


def mla_attention(c_q, c_kv, k_rope, q_norm_g, w_uq, kv_norm_g, w_ukv, cos, sin):
    B, S, _ = c_q.shape
    q = (rms_norm(c_q, q_norm_g) @ w_uq).reshape(B, S, MLA_HEADS, MLA_NOPE_DIM + MLA_ROPE_DIM)
    q_nope, q_rope = q[..., :MLA_NOPE_DIM], q[..., MLA_NOPE_DIM:]
    q_rope = apply_rope(q_rope, cos[:, :, None, :], sin[:, :, None, :])
    k_rope = apply_rope(k_rope, cos, sin)
    kv = (rms_norm(c_kv, kv_norm_g) @ w_ukv).reshape(B, S, MLA_HEADS, MLA_NOPE_DIM + MLA_V_DIM)
    k_nope, v = kv[..., :MLA_NOPE_DIM], kv[..., MLA_NOPE_DIM:]
    scale = (MLA_NOPE_DIM + MLA_ROPE_DIM) ** -0.5
    nb = S // Q_BLOCK
    qn_b = q_nope.reshape(B, nb, Q_BLOCK, MLA_HEADS, MLA_NOPE_DIM).transpose(1, 0, 2, 3, 4)
    qr_b = q_rope.reshape(B, nb, Q_BLOCK, MLA_HEADS, MLA_ROPE_DIM).transpose(1, 0, 2, 3, 4)
    key_idx = jnp.arange(S)

    def one_block(args):
        qn, qr, start = args
        s = (jnp.einsum('bqhd,bkhd->bhqk', qn, k_nope)
             + jnp.einsum('bqhr,bkr->bhqk', qr, k_rope)).astype(jnp.float32) * scale
        q_idx = start + jnp.arange(Q_BLOCK)
        s = jnp.where(key_idx[None, :] <= q_idx[:, None], s, -jnp.inf)
        p = jax.nn.softmax(s, axis=-1)
        return jnp.einsum('bhqk,bkhd->bqhd', p.astype(v.dtype), v)

    out = lax.map(one_block, (qn_b, qr_b, jnp.arange(nb) * Q_BLOCK))
    return out.transpose(1, 0, 2, 3, 4).reshape(B, S, MLA_WIDTH)


def dilated_group(q, k, v, window, dilation):
    B, S, H, Dh = q.shape
    L = S // dilation
    sub_window = window // dilation
    L_pad = -(-L // Q_BLOCK) * Q_BLOCK
    BD = B * dilation
    nb = L_pad // Q_BLOCK

    def to_sub(t):
        t = t.reshape(B, L, dilation, H, Dh).transpose(0, 2, 3, 1, 4).reshape(BD, H, L, Dh)
        return jnp.pad(t, ((0, 0), (0, 0), (0, L_pad - L), (0, 0)))

    qs, ks, vs = to_sub(q), to_sub(k), to_sub(v)
    qb = qs.reshape(BD, H, nb, Q_BLOCK, Dh)

    def band(t):
        tp = jnp.pad(t, ((0, 0), (0, 0), (Q_BLOCK, 0), (0, 0)))
        prev = tp[:, :, :L_pad].reshape(BD, H, nb, Q_BLOCK, Dh)
        cur = t.reshape(BD, H, nb, Q_BLOCK, Dh)
        return jnp.concatenate([prev, cur], axis=3)

    kb, vb = band(ks), band(vs)
    s = jnp.einsum('zhnqd,zhnkd->zhnqk', qb, kb).astype(jnp.float32) * (Dh ** -0.5)
    blk = jnp.arange(nb)[:, None, None] * Q_BLOCK
    qi = blk + jnp.arange(Q_BLOCK)[None, :, None]
    kj = blk - Q_BLOCK + jnp.arange(2 * Q_BLOCK)[None, None, :]
    dist = qi - kj
    mask = (dist >= 0) & (dist <= sub_window) & (kj >= 0)
    s = jnp.where(mask, s, -jnp.inf)
    m = jnp.max(s, axis=-1, keepdims=True)
    p = jnp.exp(s - m)
    denom = jnp.sum(p, axis=-1, keepdims=True)
    o = jnp.einsum('zhnqk,zhnkd->zhnqd', (p / denom).astype(v.dtype), vb)
    lse = (m + jnp.log(denom))[..., 0]
    o = o.reshape(BD, H, L_pad, Dh)[:, :, :L]
    o = o.reshape(B, dilation, H, L, Dh).transpose(0, 3, 1, 2, 4).reshape(B, S, H, Dh)
    lse = lse.reshape(BD, H, L_pad)[:, :, :L]
    lse = lse.reshape(B, dilation, H, L).transpose(0, 3, 1, 2).reshape(B, S, H)
    return o, lse


def dilated_attention(qkv, cos, sin):
    B, S, _ = qkv.shape
    qkv = qkv.reshape(B, S, 3, DIL_GROUPS, DIL_HEADS_PER_GROUP, DIL_HEAD_DIM)
    c, s_ = cos[:, :, None, None, :], sin[:, :, None, None, :]
    q = partial_rope(qkv[:, :, 0], c, s_, DIL_ROPE_DIM)
    k = partial_rope(qkv[:, :, 1], c, s_, DIL_ROPE_DIM)
    v = qkv[:, :, 2]
    outs, lses = [], []
    for g, (window, dilation) in enumerate(DIL_PATTERNS):
        o, lse = dilated_group(q[:, :, g], k[:, :, g], v[:, :, g], window, dilation)
        outs.append(o)
        lses.append(lse)
    alpha = jax.nn.softmax(jnp.stack(lses, axis=0), axis=0)
    out = jnp.sum(alpha[..., None].astype(v.dtype) * jnp.stack(outs, axis=0), axis=0)
    return out.reshape(B, S, DIL_WIDTH)


def setup_inputs(seed: int = 0) -> dict:
    key = jax.random.key(seed)
    ks = jax.random.split(key, 13)
    f32 = jnp.float32

    def w(k, shape, fan_in):
        return jax.random.normal(k, shape, f32) * (fan_in ** -0.5)

    def gain(k, n):
        return 1.0 + 0.02 * jax.random.normal(k, (DEPTH, n), f32)

    x = jax.random.normal(ks[0], (BATCH, SEQ, D_MODEL), f32)
    start = jax.random.randint(ks[1], (BATCH, 1), 0, 4096, dtype=jnp.int32)
    positions = start + jnp.arange(SEQ, dtype=jnp.int32)[None, :]
    return {
        "x": x,
        "positions": positions,
        "pre_norm_g": gain(ks[2], D_MODEL),
        "w_in": w(ks[3], (DEPTH, D_MODEL, IN_WIDTH), D_MODEL),
        "q_norm_g": gain(ks[4], MLA_Q_RANK),
        "w_uq": w(ks[5], (DEPTH, MLA_Q_RANK, MLA_HEADS * (MLA_NOPE_DIM + MLA_ROPE_DIM)), MLA_Q_RANK),
        "kv_norm_g": gain(ks[6], MLA_KV_RANK),
        "w_ukv": w(ks[7], (DEPTH, MLA_KV_RANK, MLA_HEADS * (MLA_NOPE_DIM + MLA_V_DIM)), MLA_KV_RANK),
        "w_proj_mla": w(ks[8], (DEPTH, MLA_WIDTH, D_MODEL), MLA_WIDTH),
        "w_proj_dil": w(ks[9], (DEPTH, DIL_WIDTH, D_MODEL), DIL_WIDTH),
        "w_out": w(ks[10], (DEPTH, D_MODEL, D_MODEL), D_MODEL),
        "post_norm_g": gain(ks[11], D_MODEL),
    }


def reference(x, positions, pre_norm_g, w_in, q_norm_g, w_uq, kv_norm_g, w_ukv,
              w_proj_mla, w_proj_dil, w_out, post_norm_g):
    cos_mla, sin_mla = rope_tables(positions, MLA_ROPE_DIM)
    cos_dil, sin_dil = rope_tables(positions, DIL_ROPE_DIM)
    split_at = [int(i) for i in np.cumsum(IN_SPLITS)[:-1]]
    for layer in range(DEPTH):
        h = rms_norm(x, pre_norm_g[layer])
        proj = h @ w_in[layer]
        c_q, c_kv, k_rope, qkv_dil, z_mla, z_dil, g_mla, g_dil = jnp.split(proj, split_at, axis=-1)
        y_mla = mla_attention(c_q, c_kv, k_rope, q_norm_g[layer], w_uq[layer],
                              kv_norm_g[layer], w_ukv[layer], cos_mla, sin_mla)
        y_dil = dilated_attention(qkv_dil, cos_dil, sin_dil)
        y_mla = (y_mla * jax.nn.silu(z_mla)) @ w_proj_mla[layer]
        y_dil = (y_dil * jax.nn.silu(z_dil)) @ w_proj_dil[layer]
        merged = jax.nn.sigmoid(g_mla) * y_mla + jax.nn.sigmoid(g_dil) * y_dil
        x = x + rms_norm(merged @ w_out[layer], post_norm_g[layer])
    return x
```

```cpp
#define DEBUG_NAIVE_MLA 0
#define DEBUG_NAIVE_DIL 0
#define DEBUG_NAIVE_GEMM 0
#define DEBUG_CHECK 0
#define N_LAUNCH_MODE 1
#include <hip/hip_runtime.h>
#include <hip/hip_cooperative_groups.h>
#include <cstdio>
#include <cstdint>
#include <cmath>
namespace cg = cooperative_groups;
namespace pg8 {
#define PG8_LAS __attribute__((address_space(3)))
typedef unsigned short bf16_t;
typedef short bf16x8 __attribute__((ext_vector_type(8)));
typedef float f32x4 __attribute__((ext_vector_type(4)));
typedef unsigned u32x4 __attribute__((ext_vector_type(4)));
constexpr int BM = 256, BK = 64, HALF = 128, HTB = HALF * BK * 2  , STAGE_BYTES = 8 * HTB, NXCD = 8, WGM = 8;

__host__ __device__ __forceinline__ int lds_byte(int r, int c) { const int st = (r >> 4) * 2 + (c >> 5), rr = r & 15, cc = c & 31, ob = rr * 64 + cc * 2; return st * 1024 + (ob ^ (((ob >> 9) & 1) << 5)); }
__host__ __device__ __forceinline__ void stage_rc(int b, int& R, int& C) { const int st = b / 1024, sb = b % 1024, swz = sb ^ (((sb >> 9) & 1) << 5); R = (st >> 1) * 16 + swz / 64; C = (st & 1) * 32 + (swz % 64) / 2; }
__host__ __device__ __forceinline__ int perm32(int rho) { const int n = rho >> 4, i = rho & 15; return 8 * (i >> 2) + 4 * n + (i & 3); }

struct Unit { int pm, pn; };
struct Gemm { const bf16_t* A; const bf16_t* Bt; int M, N, K; int lda; };

struct StaticOrder {
    int nM, nN, nwg, G, c;
    __host__ __device__ void init(int M, int N, int G_, int c_) { nM = M / BM; nN = N / BM; nwg = nM * nN; G = G_; c = c_; }
    __host__ __device__ bool next(int i, Unit& u) const {
        const long L = (long)i * G + c; if (L >= nwg) return false;
        int wgid = (int)L; { const int q = nwg / NXCD, r = nwg % NXCD, xcd = wgid % NXCD, off = wgid / NXCD; wgid = (xcd < r ? xcd * (q + 1) : r * (q + 1) + (xcd - r) * q) + off; }
        const int nig = WGM * nN, gid = wgid / nig, fm = gid * WGM, gsz = (nM - fm) < WGM ? (nM - fm) : WGM;
        u.pm = fm + ((wgid % nig) % gsz); u.pn = (wgid % nig) / gsz; return true;
    }
    __device__ __forceinline__ void a_ready(const Unit&) const {}
    __device__ __forceinline__ void done(const Unit&) const {}
};

typedef float f32x2c_t __attribute__((ext_vector_type(2))); typedef __bf16 bf16x2c_t __attribute__((ext_vector_type(2)));
__device__ __forceinline__ unsigned cvt_pk_bf16(float lo, float hi) { f32x2c_t v = {lo, hi}; bf16x2c_t b = __builtin_convertvector(v, bf16x2c_t); return __builtin_bit_cast(unsigned, b); }
typedef float f32x2 __attribute__((ext_vector_type(2)));
typedef unsigned u32x4v __attribute__((ext_vector_type(4)));
typedef unsigned u32x2v __attribute__((ext_vector_type(2)));
__device__ __forceinline__ float bf_lo(unsigned w) { return __uint_as_float(w << 16); }
__device__ __forceinline__ float bf_hi(unsigned w) { return __uint_as_float(w & 0xffff0000u); }
__device__ __forceinline__ float sigm_f(float v) { return __builtin_amdgcn_rcpf(1.f + __builtin_amdgcn_exp2f(-1.4426950408889634f * v)); }
__device__ __forceinline__ float silu_f(float v) { return v * sigm_f(v); }
__device__ __forceinline__ u32x4v pack8(const f32x4& v0, const f32x4& v1) { u32x4v w; w.x = cvt_pk_bf16(v0[0], v0[1]); w.y = cvt_pk_bf16(v0[2], v0[3]); w.z = cvt_pk_bf16(v1[0], v1[1]); w.w = cvt_pk_bf16(v1[2], v1[3]); return w; }
#define EPI_LOOP_BEGIN(base_, ldc_, colt_) { const int row0_ = u.pm * BM + wr * 64 + fr; const int col0_ = (colt_) + wc * 32 + 8 * fq; \
    _Pragma("unroll") for (int ai = 0; ai < 2; ++ai) _Pragma("unroll") for (int m = 0; m < 4; ++m) { const size_t roff_ = (size_t)(row0_ + ai * HALF + m * 16); \
    _Pragma("unroll") for (int bj = 0; bj < 2; ++bj) { f32x4 v0 = acc[ai][bj][m][0], v1 = acc[ai][bj][m][1]; const int cc_ = col0_ + bj * HALF; bf16_t* optr = (base_) + roff_ * (ldc_) + cc_;
#define EPI_LOOP_END } } }
struct EpiIn {
    static constexpr bool PERM = true, AFTER_DRAIN = false;
    bf16_t *QKVD, *ZM, *ZD, *CL; float *ssq_q, *ssq_kv;
    __device__ __forceinline__ void operator()(const f32x4 (&acc)[2][2][4][2], const Unit& u, int wr, int wc, int fr, int fq) const {
        const int pn = u.pn; bf16_t* base; int ldc, colt; bool act = false;
        if (pn < 18) { base = QKVD; ldc = 4608; colt = pn * 256; }
        else if (pn < 20) { base = ZM; ldc = 512; colt = (pn - 18) * 256; act = true; }
        else if (pn < 22) { base = ZD; ldc = 512; colt = (pn - 20) * 256; act = true; }
        else { base = CL; ldc = 768; colt = (pn - 22) * 256;
            const int row0s = u.pm * BM + wr * 64 + fr;
#pragma unroll
            for (int ai = 0; ai < 2; ++ai)
#pragma unroll
                for (int m = 0; m < 4; ++m)
#pragma unroll
                    for (int bj = 0; bj < 2; ++bj) { const f32x4 a0 = acc[ai][bj][m][0], a1 = acc[ai][bj][m][1];
                        float sacc = (a0[0] * a0[0] + a0[1] * a0[1]) + (a0[2] * a0[2] + a0[3] * a0[3]) + (a1[0] * a1[0] + a1[1] * a1[1]) + (a1[2] * a1[2] + a1[3] * a1[3]);
                        sacc += __shfl_xor(sacc, 16); sacc += __shfl_xor(sacc, 32);
                        const int seg = (pn - 22) * 2 + bj;
                        if (fq == 0 && seg < 5) atomicAdd((seg < 3 ? ssq_q : ssq_kv) + row0s + ai * HALF + m * 16, sacc); } }
        EPI_LOOP_BEGIN(base, ldc, colt)
            if (act) { _Pragma("unroll") for (int e = 0; e < 4; ++e) { v0[e] = silu_f(v0[e]); v1[e] = silu_f(v1[e]); } }
            *(u32x4v*)optr = pack8(v0, v1);
        EPI_LOOP_END
    }
};
struct EpiSig {
    static constexpr bool PERM = true, AFTER_DRAIN = false;
    bf16_t* O; int ldc;
    __device__ __forceinline__ void operator()(const f32x4 (&acc)[2][2][4][2], const Unit& u, int wr, int wc, int fr, int fq) const {
        EPI_LOOP_BEGIN(O, ldc, u.pn * 256)
            _Pragma("unroll") for (int e = 0; e < 4; ++e) { v0[e] = sigm_f(v0[e]) * 255.0f + 0.5f; v1[e] = sigm_f(v1[e]) * 255.0f + 0.5f; }
            unsigned char* bp = (unsigned char*)O + roff_ * (size_t)ldc + cc_;
            u32x2v w; w.x = (unsigned)v0[0] | ((unsigned)v0[1] << 8) | ((unsigned)v0[2] << 16) | ((unsigned)v0[3] << 24); w.y = (unsigned)v1[0] | ((unsigned)v1[1] << 8) | ((unsigned)v1[2] << 16) | ((unsigned)v1[3] << 24);
            *(u32x2v*)bp = w; (void)optr;
        EPI_LOOP_END
    }
};
struct EpiStore {
    static constexpr bool PERM = true, AFTER_DRAIN = false;
    bf16_t* O0; int ld0; int split; bf16_t* O1; int ld1;
    __device__ __forceinline__ void operator()(const f32x4 (&acc)[2][2][4][2], const Unit& u, int wr, int wc, int fr, int fq) const {
        const bool first = u.pn < split; bf16_t* base = first ? O0 : O1; const int ldc = first ? ld0 : ld1; const int colt = (first ? u.pn : u.pn - split) * 256;
        EPI_LOOP_BEGIN(base, ldc, colt)
            *(u32x4v*)optr = pack8(v0, v1);
        EPI_LOOP_END
    }
};
struct EpiScaleStore {
    static constexpr bool PERM = true, AFTER_DRAIN = false;
    bf16_t* O0; int ld0; int split; bf16_t* O1; int ld1; const float* ssq; float invn;
    __device__ __forceinline__ void operator()(const f32x4 (&acc)[2][2][4][2], const Unit& u, int wr, int wc, int fr, int fq) const {
        const bool first = u.pn < split; bf16_t* base = first ? O0 : O1; const int ldc = first ? ld0 : ld1; const int colt = (first ? u.pn : u.pn - split) * 256;
        float rs[2][4];
#pragma unroll
        for (int ai = 0; ai < 2; ++ai)
#pragma unroll
            for (int m = 0; m < 4; ++m) rs[ai][m] = 1.0f / sqrtf(ssq[u.pm * BM + wr * 64 + fr + ai * HALF + m * 16] * invn + 1e-6f);
        EPI_LOOP_BEGIN(base, ldc, colt)
            v0 = v0 * rs[ai][m]; v1 = v1 * rs[ai][m];
            *(u32x4v*)optr = pack8(v0, v1);
        EPI_LOOP_END
    }
};
template <bool ADD> struct EpiGate {
    static constexpr bool PERM = true, AFTER_DRAIN = false;
    bf16_t* O; int ldc; const bf16_t* G; int ldg; int goff;
    __device__ __forceinline__ void operator()(const f32x4 (&acc)[2][2][4][2], const Unit& u, int wr, int wc, int fr, int fq) const {
        EPI_LOOP_BEGIN(O, ldc, u.pn * 256)
            const u32x2v g = *(const u32x2v*)((const unsigned char*)G + roff_ * (size_t)ldg + goff + cc_);
            constexpr float k_ = 1.0f / 255.0f;
            v0[0] *= (float)(g.x & 255u) * k_; v0[1] *= (float)((g.x >> 8) & 255u) * k_; v0[2] *= (float)((g.x >> 16) & 255u) * k_; v0[3] *= (float)(g.x >> 24) * k_;
            v1[0] *= (float)(g.y & 255u) * k_; v1[1] *= (float)((g.y >> 8) & 255u) * k_; v1[2] *= (float)((g.y >> 16) & 255u) * k_; v1[3] *= (float)(g.y >> 24) * k_;
            if (ADD) { const u32x4v p = *(const u32x4v*)optr;
                v0[0] += bf_lo(p.x); v0[1] += bf_hi(p.x); v0[2] += bf_lo(p.y); v0[3] += bf_hi(p.y); v1[0] += bf_lo(p.z); v1[1] += bf_hi(p.z); v1[2] += bf_lo(p.w); v1[3] += bf_hi(p.w); }
            *(u32x4v*)optr = pack8(v0, v1);
        EPI_LOOP_END
    }
};
struct GateOrder {
    StaticOrder S;
    __host__ __device__ bool next(int i, Unit& u) const { if (!S.next(i >> 1, u)) return false; u.pn += 4 * (i & 1); return true; }
    __device__ __forceinline__ void a_ready(const Unit&) const {}
    __device__ __forceinline__ void done(const Unit&) const {}
};
template <class Epi, class Sched, bool ALIGN_EPI = false, bool SP2 = false>
__device__ __forceinline__ void gemm_phase(PG8_LAS unsigned char* lds, const Gemm g, const Sched& S, const Epi& E) {
    const int tid = threadIdx.x, wid = __builtin_amdgcn_readfirstlane(tid >> 6), lane = tid & 63, wr = wid >> 2, wc = wid & 3, fr = lane & 15, fq = lane >> 4;
    const int K = g.K, nt = K / BK;
    const int lda = g.lda ? g.lda : K;
    unsigned voffA[2], voffB[2];
#pragma unroll
    for (int i = 0; i < 2; ++i) { int R, C; stage_rc(tid * 16 + i * 8192, R, C); const int Rb = Epi::PERM ? ((R & ~31) + perm32(R & 31)) : R;
        voffA[i] = (unsigned)(R * lda + C) * 2u; voffB[i] = (unsigned)(Rb * K + C) * 2u; }
    const size_t kstep = (size_t)(BK * 2);
    const size_t hstep = (size_t)HALF * K * 2;
    const size_t tstep = 2 * hstep;
    const size_t hstepA = (size_t)HALF * lda * 2, tstepA = 2 * hstepA;
    const unsigned ldsw = (unsigned)wid * 1024u;
    const int aoff = lds_byte(wr * 64 + fr, fq * 8), boff = lds_byte(wc * 32 + fr, fq * 8);
#define PG8_SA(b, h) (((b) * 2 + (h)) * HTB)
#define PG8_SB(b, h) ((4 + (b) * 2 + (h)) * HTB)
#define PG8_STAGE(bufoff, gbase, voff) do { _Pragma("unroll") for (int _i = 0; _i < 2; ++_i) \
        __builtin_amdgcn_global_load_lds((const unsigned*)((const char*)(gbase) + (voff)[_i]), (PG8_LAS unsigned*)(lds + (bufoff) + ldsw + _i * 8192), 16, 0, 0); } while (0)
#define PG8_LDA(dst, b, h) do { _Pragma("unroll") for (int m = 0; m < 4; ++m) _Pragma("unroll") for (int k = 0; k < 2; ++k) dst[m][k] = *(const PG8_LAS bf16x8*)(lds + PG8_SA(b, h) + aoff + m * 2048 + k * 1024); } while (0)
#define PG8_LDB(dst, b, h) do { _Pragma("unroll") for (int n = 0; n < 2; ++n) _Pragma("unroll") for (int k = 0; k < 2; ++k) dst[n][k] = *(const PG8_LAS bf16x8*)(lds + PG8_SB(b, h) + boff + n * 2048 + k * 1024); } while (0)
#define PG8_MMA(ai, bj, At, Bt) do { __builtin_amdgcn_s_setprio(1); _Pragma("unroll") for (int m = 0; m < 4; ++m) _Pragma("unroll") for (int n = 0; n < 2; ++n) _Pragma("unroll") for (int k = 0; k < 2; ++k) \
        acc[ai][bj][m][n] = __builtin_amdgcn_mfma_f32_16x16x32_bf16(Bt[n][k], At[m][k], acc[ai][bj][m][n], 0, 0, 0); __builtin_amdgcn_s_setprio(0); } while (0)
#define PG8_WAIT_V(n) asm volatile("s_waitcnt vmcnt(" #n ")" ::: "memory")
#define PG8_WAIT_L(n) asm volatile("s_waitcnt lgkmcnt(" #n ")" ::: "memory")
#define PG8_BAR __builtin_amdgcn_s_barrier()
#define PG8_SCHED __builtin_amdgcn_sched_barrier(0)
    Unit cur, nxt; int ui = 0;
    if (!S.next(0, cur)) return;
    f32x4 acc[2][2][4][2];
#pragma unroll
    for (int a = 0; a < 2; ++a)
#pragma unroll
        for (int b = 0; b < 2; ++b)
#pragma unroll
            for (int m = 0; m < 4; ++m)
#pragma unroll
                for (int n = 0; n < 2; ++n) acc[a][b][m][n] = (f32x4){0.f, 0.f, 0.f, 0.f};
    bf16x8 At[4][2], B0[2][2], B1[2][2];
    const char* cA = (const char*)g.A + (size_t)cur.pm * tstepA; const char* cB = (const char*)g.Bt + (size_t)cur.pn * tstep;
    S.a_ready(cur);
    if constexpr (SP2) {
        PG8_STAGE(PG8_SB(0, 0), cB, voffB); PG8_STAGE(PG8_SB(0, 1), cB + hstep, voffB); PG8_STAGE(PG8_SA(0, 0), cA, voffA); PG8_STAGE(PG8_SA(0, 1), cA + hstepA, voffA);
        if (wr == 1) PG8_BAR;
        PG8_WAIT_V(2); PG8_BAR;
        PG8_STAGE(PG8_SB(1, 0), cB + kstep, voffB); PG8_STAGE(PG8_SA(1, 0), cA + kstep, voffA); PG8_STAGE(PG8_SB(1, 1), cB + hstep + kstep, voffB);
        PG8_WAIT_V(6); PG8_BAR;
    } else {
        PG8_STAGE(PG8_SB(0, 0), cB, voffB); PG8_STAGE(PG8_SA(0, 0), cA, voffA); PG8_STAGE(PG8_SB(0, 1), cB + hstep, voffB); PG8_STAGE(PG8_SA(0, 1), cA + hstepA, voffA);
        if (wr == 1) PG8_BAR;
        PG8_WAIT_V(4); PG8_BAR;
        PG8_STAGE(PG8_SB(1, 0), cB + kstep, voffB); PG8_STAGE(PG8_SA(1, 0), cA + kstep, voffA); PG8_STAGE(PG8_SB(1, 1), cB + hstep + kstep, voffB);
        PG8_WAIT_V(6); PG8_BAR;
    }
    for (;;) {
        const bool has_next = S.next(ui + 1, nxt);
        const char* nA = has_next ? (const char*)g.A + (size_t)nxt.pm * tstepA : cA; const char* nB = has_next ? (const char*)g.Bt + (size_t)nxt.pn * tstep : cB;
        for (int t = 0; t < nt; t += 2) {
            const bool last = (t == nt - 2);
            const char* a1 = cA + (size_t)(t + 1) * kstep;
            const char* a2 = last ? nA : cA + (size_t)(t + 2) * kstep; const char* b2 = last ? nB : cB + (size_t)(t + 2) * kstep;
            const char* a3 = a2 + kstep; const char* b3 = b2 + kstep;
            if (last && has_next) S.a_ready(nxt);
            if constexpr (SP2) {
            PG8_LDB(B0, 0, 0); PG8_LDB(B1, 0, 1); PG8_SCHED; PG8_LDA(At, 0, 0); PG8_STAGE(PG8_SA(1, 1), a1 + hstepA, voffA);
            PG8_WAIT_V(8); PG8_WAIT_L(0); PG8_BAR; PG8_MMA(0, 0, At, B0); PG8_MMA(0, 1, At, B1); PG8_BAR; PG8_SCHED;
            PG8_LDA(At, 0, 1); PG8_STAGE(PG8_SB(0, 0), b2, voffB); PG8_STAGE(PG8_SB(0, 1), b2 + hstep, voffB); PG8_STAGE(PG8_SA(0, 0), a2, voffA);
            PG8_WAIT_V(8); PG8_WAIT_L(0); PG8_BAR; PG8_MMA(1, 0, At, B0); PG8_MMA(1, 1, At, B1); PG8_BAR; PG8_SCHED;
            PG8_LDB(B0, 1, 0); PG8_LDB(B1, 1, 1); PG8_SCHED; PG8_LDA(At, 1, 0); PG8_STAGE(PG8_SA(0, 1), a2 + hstepA, voffA);
            PG8_WAIT_V(8); PG8_WAIT_L(0); PG8_BAR; PG8_MMA(0, 0, At, B0); PG8_MMA(0, 1, At, B1); PG8_BAR; PG8_SCHED;
            PG8_LDA(At, 1, 1); PG8_STAGE(PG8_SB(1, 0), b3, voffB); PG8_STAGE(PG8_SB(1, 1), b3 + hstep, voffB); PG8_STAGE(PG8_SA(1, 0), a3, voffA);
            PG8_WAIT_V(8); PG8_WAIT_L(0); PG8_BAR; PG8_MMA(1, 0, At, B0); PG8_MMA(1, 1, At, B1); PG8_BAR; PG8_SCHED;
            } else {
            PG8_LDB(B0, 0, 0); PG8_SCHED; PG8_LDA(At, 0, 0); PG8_STAGE(PG8_SA(1, 1), a1 + hstepA, voffA);
            PG8_WAIT_L(8); PG8_BAR; PG8_WAIT_L(0); PG8_MMA(0, 0, At, B0); PG8_BAR; PG8_SCHED;
            PG8_LDB(B1, 0, 1); PG8_STAGE(PG8_SB(0, 0), b2, voffB);
            PG8_BAR; PG8_WAIT_L(0); PG8_MMA(0, 1, At, B1); PG8_BAR;
            PG8_LDA(At, 0, 1); PG8_STAGE(PG8_SA(0, 0), a2, voffA);
            PG8_BAR; PG8_WAIT_L(0); PG8_MMA(1, 0, At, B0); PG8_BAR; PG8_SCHED;
            PG8_STAGE(PG8_SB(0, 1), b2 + hstep, voffB);
            PG8_WAIT_V(6); PG8_BAR; PG8_MMA(1, 1, At, B1); PG8_BAR;
            PG8_LDB(B0, 1, 0); PG8_SCHED; PG8_LDA(At, 1, 0); PG8_STAGE(PG8_SA(0, 1), a2 + hstepA, voffA);
            PG8_WAIT_L(8); PG8_BAR; PG8_WAIT_L(0); PG8_MMA(0, 0, At, B0); PG8_BAR; PG8_SCHED;
            PG8_LDB(B1, 1, 1); PG8_STAGE(PG8_SB(1, 0), b3, voffB);
            PG8_BAR; PG8_WAIT_L(0); PG8_MMA(0, 1, At, B1); PG8_BAR;
            PG8_LDA(At, 1, 1); PG8_STAGE(PG8_SA(1, 0), a3, voffA);
            PG8_BAR; PG8_WAIT_L(0); PG8_MMA(1, 0, At, B0); PG8_BAR; PG8_SCHED;
            PG8_STAGE(PG8_SB(1, 1), b3 + hstep, voffB);
            PG8_WAIT_V(6); PG8_BAR; PG8_MMA(1, 1, At, B1); PG8_BAR;
            }
        }
        if constexpr (ALIGN_EPI) { if (wr == 0) PG8_BAR; }
        if constexpr (!Epi::AFTER_DRAIN) { E(acc, cur, wr, wc, fr, fq); S.done(cur); }
        if (!has_next) break;
#pragma unroll
        for (int a = 0; a < 2; ++a)
#pragma unroll
            for (int b = 0; b < 2; ++b)
#pragma unroll
                for (int m = 0; m < 4; ++m)
#pragma unroll
                    for (int n = 0; n < 2; ++n) acc[a][b][m][n] = (f32x4){0.f, 0.f, 0.f, 0.f};
        cur = nxt; cA = nA; cB = nB; ++ui;
        if constexpr (ALIGN_EPI) { if (wr == 1) PG8_BAR; }
    }
    PG8_WAIT_V(0);
    if constexpr (!ALIGN_EPI) { if (wr == 0) PG8_BAR; }
    PG8_BAR;
    if constexpr (Epi::AFTER_DRAIN) { E.fused(acc, cur, wr, wc, fr, fq, lds, wid, lane); S.done(cur); }
#undef PG8_SA
#undef PG8_SB
#undef PG8_STAGE
#undef PG8_LDA
#undef PG8_LDB
#undef PG8_MMA
#undef PG8_WAIT_V
#undef PG8_WAIT_L
#undef PG8_BAR
#undef PG8_SCHED
}
}

namespace att {
#define LAS __attribute__((address_space(3)))
typedef unsigned short bf16_t;
typedef short bf16x8 __attribute__((ext_vector_type(8)));
typedef short s16x4 __attribute__((ext_vector_type(4)));
typedef float f32x16 __attribute__((ext_vector_type(16)));
typedef unsigned u32x4 __attribute__((ext_vector_type(4)));
typedef unsigned u32x2 __attribute__((ext_vector_type(2)));
typedef float f32x4a __attribute__((ext_vector_type(4)));
constexpr int KBUF = 64 * 208, VSTR = 192, VBUF = 64 * VSTR;
constexpr int KOFF = 0, VOFF = 2 * KBUF, WSF_OFF = VOFF + 2 * VBUF, ATT_LDS = WSF_OFF + 8 * 64 * 4;
__device__ __forceinline__ int crow(int r, int hi) { return (r & 3) + 8 * (r >> 2) + 4 * hi; }
__device__ __forceinline__ unsigned pk_bf16(float lo, float hi) { return pg8::cvt_pk_bf16(lo, hi); }
__device__ __forceinline__ float bf2f(bf16_t b) { return __uint_as_float((unsigned)b << 16); }
__device__ __forceinline__ bf16_t f2bf(float f) { return (bf16_t)(pk_bf16(f, 0.f) & 0xffffu); }
__device__ __forceinline__ float xhalf(float v) { return __shfl_xor(v, 32); }

struct UnitDesc {
    const bf16_t* Q; long q_rs;
    const bf16_t* K; long k_rs;
    const bf16_t* K2; long k2_rs;
    const bf16_t* V; long v_rs;
    const float* cs; const float* sn;
    bf16_t* O; long o_rs;
    float* lse; long lse_rs;
    int q0; int W; float c2;
};

template <bool MLA>
__device__ __forceinline__ void attn_unit(LAS unsigned char* lds, const UnitDesc& d) {
    constexpr int DQK = MLA ? 96 : 64, NKS = DQK / 16, KSTR = DQK * 2 + 16;
    const int tid = threadIdx.x, lane = tid & 63, r32 = lane & 31, hi = lane >> 5;
    const int wid = __builtin_amdgcn_readfirstlane(tid >> 6);
    const int a = d.q0 + wid * 32, qi = a + r32;
    LAS float* wsf = (LAS float*)(lds + WSF_OFF) + wid * 64;
    bf16x8 qr[NKS];
    { const bf16_t* qp = d.Q + (long)qi * d.q_rs + hi * 8;
#pragma unroll
      for (int ks = 0; ks < NKS; ++ks) qr[ks] = *(const bf16x8*)(qp + ks * 16); }
    if constexpr (MLA) {
        const float* cp = d.cs + (long)qi * 16 + hi * 8; const float* sp = d.sn + (long)qi * 16 + hi * 8;
        bf16x8 n1, n2;
#pragma unroll
        for (int e = 0; e < 8; ++e) { const float c = cp[e], s = sp[e], x1 = bf2f((bf16_t)qr[4][e]), x2 = bf2f((bf16_t)qr[5][e]);
            n1[e] = (short)f2bf(x1 * c - x2 * s); n2[e] = (short)f2bf(x2 * c + x1 * s); }
        qr[4] = n1; qr[5] = n2;
    }
    const int j_lo = (d.q0 - d.W > 0 ? d.q0 - d.W : 0) >> 6, j_hi = (d.q0 + 255) >> 6;
    const int wj_lo = (a - d.W > 0 ? a - d.W : 0) >> 6, wj_hi = (a + 31) >> 6;
    const int srow = tid >> 3, sch = tid & 7, s2row = (tid >> 2) & 63, s2ch = tid & 3;
    const bf16_t* kg = d.K + (long)srow * d.k_rs + sch * 8; const bf16_t* vg = d.V + (long)srow * d.v_rs + sch * 8;
    const bf16_t* k2g = MLA ? d.K2 + (long)s2row * d.k2_rs + s2ch * 8 : nullptr;
    const int kst = srow * KSTR + sch * 16, k2st = s2row * KSTR + 128 + s2ch * 16, vst = srow * VSTR + sch * 16;
    u32x4 kreg, vreg, k2reg = {0u, 0u, 0u, 0u};
#define ATT_LOAD(j) do { kreg = *(const u32x4*)(kg + (long)(j) * 64 * d.k_rs); vreg = *(const u32x4*)(vg + (long)(j) * 64 * d.v_rs); \
        if (MLA && tid < 256) k2reg = *(const u32x4*)(k2g + (long)(j) * 64 * d.k2_rs); } while (0)
#define ATT_STORE(buf) do { *(LAS u32x4*)(lds + KOFF + (buf) * KBUF + kst) = kreg; *(LAS u32x4*)(lds + VOFF + (buf) * VBUF + vst) = vreg; \
        if (MLA && tid < 256) *(LAS u32x4*)(lds + KOFF + (buf) * KBUF + k2st) = k2reg; } while (0)
    float m_run = -INFINITY, l_run = 0.f; f32x16 o0 = {}, o1 = {};
    ATT_LOAD(j_lo); ATT_STORE(0); __syncthreads();
    const int kro = r32 * KSTR + hi * 16;
    const int vro = (4 * hi + ((lane & 15) >> 2)) * VSTR + (16 * ((lane >> 4) & 1) + 4 * (lane & 3)) * 2;
    for (int j = j_lo; j <= j_hi; ++j) {
        const int cur = (j - j_lo) & 1;
        if (j < j_hi) ATT_LOAD(j + 1);
        if (j >= wj_lo && j <= wj_hi) {
            const LAS unsigned char* Kb = lds + KOFF + cur * KBUF + kro;
            f32x16 p0 = {}, p1 = {};
#pragma unroll
            for (int ks = 0; ks < NKS; ++ks) {
                const bf16x8 k0 = *(const LAS bf16x8*)(Kb + ks * 32), k1 = *(const LAS bf16x8*)(Kb + 32 * KSTR + ks * 32);
                p0 = __builtin_amdgcn_mfma_f32_32x32x16_bf16(k0, qr[ks], p0, 0, 0, 0);
                p1 = __builtin_amdgcn_mfma_f32_32x32x16_bf16(k1, qr[ks], p1, 0, 0, 0);
            }
            const bool need_mask = (64 * j + 63 > a) || (a + 31 - 64 * j > d.W);
            const int kvb = 64 * j + 4 * hi;
            float mx = -INFINITY;
#pragma unroll
            for (int r = 0; r < 16; ++r) {
                float s0 = p0[r] * d.c2, s1 = p1[r] * d.c2;
                if (need_mask) { const int kv = kvb + (r & 3) + 8 * (r >> 2); const int d0 = qi - kv, d1 = d0 - 32;
                    if (d0 < 0 || d0 > d.W) s0 = -INFINITY; if (d1 < 0 || d1 > d.W) s1 = -INFINITY; }
                p0[r] = s0; p1[r] = s1; mx = fmaxf(mx, fmaxf(s0, s1));
            }
            mx = fmaxf(mx, xhalf(mx));
            const float m_new = fmaxf(m_run, mx);
            const float m_use = (m_new == -INFINITY) ? 0.f : m_new;
            if (__any(m_new > m_run)) {
                const float f = __builtin_amdgcn_exp2f(m_run - m_use);
                l_run *= f;
                if (hi == 0) wsf[r32] = f;
                asm volatile("s_waitcnt lgkmcnt(0)" ::: "memory");
#pragma unroll
                for (int g = 0; g < 4; ++g) { const f32x4a fv = *(const LAS f32x4a*)(wsf + 8 * g + 4 * hi);
                    o0[4 * g + 0] *= fv.x; o0[4 * g + 1] *= fv.y; o0[4 * g + 2] *= fv.z; o0[4 * g + 3] *= fv.w;
                    o1[4 * g + 0] *= fv.x; o1[4 * g + 1] *= fv.y; o1[4 * g + 2] *= fv.z; o1[4 * g + 3] *= fv.w; }
                m_run = m_new;
            }
            float ls = 0.f;
#pragma unroll
            for (int r = 0; r < 16; ++r) { p0[r] = __builtin_amdgcn_exp2f(p0[r] - m_use); p1[r] = __builtin_amdgcn_exp2f(p1[r] - m_use); ls += p0[r] + p1[r]; }
            l_run += ls;
            bf16x8 pa[4];
#pragma unroll
            for (int s = 0; s < 2; ++s) {
                u32x4 w0, w1;
                w0.x = pk_bf16(p0[8 * s + 0], p0[8 * s + 1]); w0.y = pk_bf16(p0[8 * s + 2], p0[8 * s + 3]); w0.z = pk_bf16(p0[8 * s + 4], p0[8 * s + 5]); w0.w = pk_bf16(p0[8 * s + 6], p0[8 * s + 7]);
                w1.x = pk_bf16(p1[8 * s + 0], p1[8 * s + 1]); w1.y = pk_bf16(p1[8 * s + 2], p1[8 * s + 3]); w1.z = pk_bf16(p1[8 * s + 4], p1[8 * s + 5]); w1.w = pk_bf16(p1[8 * s + 6], p1[8 * s + 7]);
                pa[s] = __builtin_bit_cast(bf16x8, w0); pa[2 + s] = __builtin_bit_cast(bf16x8, w1);
            }
            const LAS unsigned char* Vb = lds + VOFF + cur * VBUF + vro;
#pragma unroll
            for (int s = 0; s < 4; ++s) {
#pragma unroll
                for (int d0 = 0; d0 < 2; ++d0) {
                    const LAS unsigned char* vp = Vb + (16 * s) * VSTR + d0 * 64;
                    const s16x4 lo = __builtin_bit_cast(s16x4, __builtin_amdgcn_ds_read_tr16_b64_v4i16((LAS s16x4*)vp));
                    const s16x4 hh = __builtin_bit_cast(s16x4, __builtin_amdgcn_ds_read_tr16_b64_v4i16((LAS s16x4*)(vp + 8 * VSTR)));
                    const bf16x8 vf = (bf16x8){lo[0], lo[1], lo[2], lo[3], hh[0], hh[1], hh[2], hh[3]};
                    if (d0 == 0) o0 = __builtin_amdgcn_mfma_f32_32x32x16_bf16(pa[s], vf, o0, 0, 0, 0);
                    else o1 = __builtin_amdgcn_mfma_f32_32x32x16_bf16(pa[s], vf, o1, 0, 0, 0);
                }
            }
        }
        if (j < j_hi) ATT_STORE(cur ^ 1);
        __syncthreads();
    }
#undef ATT_LOAD
#undef ATT_STORE
    const float l_tot = l_run + xhalf(l_run);
    if (hi == 0) wsf[r32] = __builtin_amdgcn_rcpf(l_tot);
    asm volatile("s_waitcnt lgkmcnt(0)" ::: "memory");
    if constexpr (!MLA) { if (hi == 0) d.lse[(long)qi * d.lse_rs] = (m_run + __builtin_amdgcn_logf(l_tot)) * 0.6931471805599453f; }
#pragma unroll
    for (int r = 0; r < 16; ++r) {
        const int row = crow(r, hi); const float inv = wsf[row];
        bf16_t* op = d.O + (long)(a + row) * d.o_rs + r32;
        if constexpr (MLA) { op[0] = f2bf(o0[r] * inv * bf2f(op[0])); op[32] = f2bf(o1[r] * inv * bf2f(op[32])); }
        else { op[0] = f2bf(o0[r] * inv); op[32] = f2bf(o1[r] * inv); }
    }
    __syncthreads();
}

constexpr int MLA_KBUF = 64 * 208, MLA_VOFF = 3 * MLA_KBUF, MLA_WSF = MLA_VOFF + 3 * VBUF, MLA_LDS = MLA_WSF + 8 * 64 * 4;
__device__ __forceinline__ void mla_pv(const LAS unsigned char* Vb, const bf16x8 (&pa)[4], f32x16& o0, f32x16& o1) {
#pragma unroll
    for (int s = 0; s < 4; ++s) {
#pragma unroll
        for (int d0 = 0; d0 < 2; ++d0) {
            const LAS unsigned char* vp = Vb + (16 * s) * VSTR + d0 * 64;
            const s16x4 lo = __builtin_bit_cast(s16x4, __builtin_amdgcn_ds_read_tr16_b64_v4i16((LAS s16x4*)vp));
            const s16x4 hh = __builtin_bit_cast(s16x4, __builtin_amdgcn_ds_read_tr16_b64_v4i16((LAS s16x4*)(vp + 8 * VSTR)));
            const bf16x8 vf = (bf16x8){lo[0], lo[1], lo[2], lo[3], hh[0], hh[1], hh[2], hh[3]};
            if (d0 == 0) o0 = __builtin_amdgcn_mfma_f32_32x32x16_bf16(pa[s], vf, o0, 0, 0, 0);
            else o1 = __builtin_amdgcn_mfma_f32_32x32x16_bf16(pa[s], vf, o1, 0, 0, 0);
        }
    }
}
__device__ __forceinline__ void mla_unit(LAS unsigned char* lds, const UnitDesc& d) {
    constexpr int NKS = 6, KSTR = 208;
    const int tid = threadIdx.x, lane = tid & 63, r32 = lane & 31, hi = lane >> 5;
    const int wid = __builtin_amdgcn_readfirstlane(tid >> 6);
    const int a = d.q0 + wid * 32, qi = a + r32;
    LAS float* wsf = (LAS float*)(lds + MLA_WSF) + wid * 64;
    bf16x8 qr[NKS];
    { const bf16_t* qp = d.Q + (long)qi * d.q_rs + hi * 8;
#pragma unroll
      for (int ks = 0; ks < NKS; ++ks) qr[ks] = *(const bf16x8*)(qp + ks * 16); }
    {
        const float* cp = d.cs + (long)qi * 16 + hi * 8; const float* sp = d.sn + (long)qi * 16 + hi * 8; const float c2 = d.c2;
        bf16x8 n1, n2;
#pragma unroll
        for (int e = 0; e < 8; ++e) { const float c = cp[e] * c2, s = sp[e] * c2, x1 = bf2f((bf16_t)qr[4][e]), x2 = bf2f((bf16_t)qr[5][e]);
            n1[e] = (short)f2bf(x1 * c - x2 * s); n2[e] = (short)f2bf(x2 * c + x1 * s); }
        qr[4] = n1; qr[5] = n2;
#pragma unroll
        for (int ks = 0; ks < 4; ++ks) { bf16x8 t;
#pragma unroll
            for (int e = 0; e < 8; ++e) t[e] = (short)f2bf(bf2f((bf16_t)qr[ks][e]) * c2);
            qr[ks] = t; }
    }
    const int j_hi = (d.q0 + 255) >> 6, wj_hi = (a + 31) >> 6;
    const int srow = tid >> 3, sch = tid & 7, s2row = (tid >> 2) & 63, s2ch = tid & 3;
    const bf16_t* kg = d.K + (long)srow * d.k_rs + sch * 8; const bf16_t* vg = d.V + (long)srow * d.v_rs + sch * 8;
    const bf16_t* k2g = d.K2 + (long)s2row * d.k2_rs + s2ch * 8;
    const int kst = srow * KSTR + sch * 16, k2st = s2row * KSTR + 128 + s2ch * 16, vst = srow * VSTR + sch * 16;
    u32x4 kreg, vreg, k2reg = {0u, 0u, 0u, 0u};
#define MLA_LOAD(j) do { kreg = *(const u32x4*)(kg + (long)(j) * 64 * d.k_rs); vreg = *(const u32x4*)(vg + (long)(j) * 64 * d.v_rs); \
        if (tid < 256) k2reg = *(const u32x4*)(k2g + (long)(j) * 64 * d.k2_rs); } while (0)
#define MLA_STORE(buf) do { *(LAS u32x4*)(lds + (buf) * MLA_KBUF + kst) = kreg; *(LAS u32x4*)(lds + MLA_VOFF + (buf) * VBUF + vst) = vreg; \
        if (tid < 256) *(LAS u32x4*)(lds + (buf) * MLA_KBUF + k2st) = k2reg; } while (0)
    const int kro = r32 * KSTR + hi * 16;
    const int vro = (4 * hi + ((lane & 15) >> 2)) * VSTR + (16 * ((lane >> 4) & 1) + 4 * (lane & 3)) * 2;
    float m_run = -INFINITY, l_run = 0.f; f32x16 o0 = {}, o1 = {}; f32x16 negm = {};
    f32x16 pA0 = {}, pA1 = {}, pB0 = {}, pB1 = {};
#define MLA_QK(P0, P1, buf) do { const LAS unsigned char* Kb_ = lds + (buf) * MLA_KBUF + kro; \
        _Pragma("unroll") for (int ks = 0; ks < NKS; ++ks) { \
            const bf16x8 k0_ = *(const LAS bf16x8*)(Kb_ + ks * 32), k1_ = *(const LAS bf16x8*)(Kb_ + 32 * KSTR + ks * 32); \
            P0 = __builtin_amdgcn_mfma_f32_32x32x16_bf16(k0_, qr[ks], ks == 0 ? negm : P0, 0, 0, 0); \
            P1 = __builtin_amdgcn_mfma_f32_32x32x16_bf16(k1_, qr[ks], ks == 0 ? negm : P1, 0, 0, 0); } } while (0)
#define MLA_STEP(PC0, PC1, PN0, PN1, j, bc, bn, b2) do { \
        const bool nx_ = (j) + 1 <= wj_hi; \
        if (nx_) MLA_QK(PN0, PN1, bn); \
        if ((j) <= wj_hi) { \
            if (64 * (j) + 63 > a) { const int kvb = 64 * (j) + 4 * hi; \
                _Pragma("unroll") for (int r = 0; r < 16; ++r) { const int kv = kvb + (r & 3) + 8 * (r >> 2); if (kv > qi) PC0[r] = -INFINITY; if (kv + 32 > qi) PC1[r] = -INFINITY; } } \
            float mx = fmaxf(PC0[0], PC1[0]); \
            _Pragma("unroll") for (int r = 1; r < 16; ++r) mx = fmaxf(fmaxf(mx, PC0[r]), PC1[r]); \
              \
            if (__any((m_run == -INFINITY) ? (mx > -INFINITY) : (mx > 8.0f))) { \
                mx = fmaxf(mx, xhalf(mx)); \
                const bool need = (m_run == -INFINITY) ? (mx > -INFINITY) : (mx > 8.0f); \
                const float dl = need ? mx : 0.f; const float f = __builtin_amdgcn_exp2f(-fmaxf(dl, 0.f)); \
                l_run *= f; if (hi == 0) wsf[r32] = f; \
                asm volatile("s_waitcnt lgkmcnt(0)" ::: "memory"); \
                _Pragma("unroll") for (int g = 0; g < 4; ++g) { const f32x4a fv = *(const LAS f32x4a*)(wsf + 8 * g + 4 * hi); \
                    o0[4 * g + 0] *= fv.x; o0[4 * g + 1] *= fv.y; o0[4 * g + 2] *= fv.z; o0[4 * g + 3] *= fv.w; \
                    o1[4 * g + 0] *= fv.x; o1[4 * g + 1] *= fv.y; o1[4 * g + 2] *= fv.z; o1[4 * g + 3] *= fv.w; } \
                _Pragma("unroll") for (int r = 0; r < 16; ++r) { PC0[r] -= dl; PC1[r] -= dl; PN0[r] -= dl; PN1[r] -= dl; } \
                m_run = ((m_run == -INFINITY) ? 0.f : m_run) + dl; \
                _Pragma("unroll") for (int r = 0; r < 16; ++r) negm[r] = -m_run; \
            } \
            float ls = 0.f; \
            _Pragma("unroll") for (int r = 0; r < 16; ++r) { PC0[r] = __builtin_amdgcn_exp2f(PC0[r]); PC1[r] = __builtin_amdgcn_exp2f(PC1[r]); ls += PC0[r] + PC1[r]; } \
            l_run += ls; \
            bf16x8 pa[4]; \
            _Pragma("unroll") for (int s = 0; s < 2; ++s) { u32x4 w0, w1; \
                w0.x = pk_bf16(PC0[8 * s + 0], PC0[8 * s + 1]); w0.y = pk_bf16(PC0[8 * s + 2], PC0[8 * s + 3]); w0.z = pk_bf16(PC0[8 * s + 4], PC0[8 * s + 5]); w0.w = pk_bf16(PC0[8 * s + 6], PC0[8 * s + 7]); \
                w1.x = pk_bf16(PC1[8 * s + 0], PC1[8 * s + 1]); w1.y = pk_bf16(PC1[8 * s + 2], PC1[8 * s + 3]); w1.z = pk_bf16(PC1[8 * s + 4], PC1[8 * s + 5]); w1.w = pk_bf16(PC1[8 * s + 6], PC1[8 * s + 7]); \
                pa[s] = __builtin_bit_cast(bf16x8, w0); pa[2 + s] = __builtin_bit_cast(bf16x8, w1); } \
            mla_pv(lds + MLA_VOFF + (bc) * VBUF + vro, pa, o0, o1); \
        } \
        if ((j) + 2 <= j_hi) MLA_STORE(b2); \
        __syncthreads(); \
        if ((j) + 3 <= j_hi) MLA_LOAD((j) + 3); \
    } while (0)
    MLA_LOAD(0); MLA_STORE(0); MLA_LOAD(1); __syncthreads();
    MLA_QK(pA0, pA1, 0);
    MLA_STORE(1); __syncthreads();
    if (2 <= j_hi) MLA_LOAD(2);
    int bc = 0;
    for (int j = 0; j < j_hi; j += 2) {
        const int bn = (bc == 2) ? 0 : bc + 1, b2 = (bn == 2) ? 0 : bn + 1;
        MLA_STEP(pA0, pA1, pB0, pB1, j, bc, bn, b2);
        MLA_STEP(pB0, pB1, pA0, pA1, j + 1, bn, b2, bc);
        bc = b2;
    }
#undef MLA_LOAD
#undef MLA_STORE
#undef MLA_QK
#undef MLA_STEP
    const float l_tot = l_run + xhalf(l_run);
    if (hi == 0) wsf[r32] = __builtin_amdgcn_rcpf(l_tot);
    asm volatile("s_waitcnt lgkmcnt(0)" ::: "memory");
#pragma unroll
    for (int r = 0; r < 16; ++r) {
        const int row = crow(r, hi); const float inv = wsf[row];
        bf16_t* op = d.O + (long)(a + row) * d.o_rs + r32;
        op[0] = f2bf(o0[r] * inv * bf2f(op[0])); op[32] = f2bf(o1[r] * inv * bf2f(op[32]));
    }
    __syncthreads();
}
constexpr int D2_KB = 64 * 144, D2_VOFF = 4 * D2_KB, D2_WSF = D2_VOFF + 4 * VBUF, D2_LDS = D2_WSF + 8 * 64 * 4;
struct Dil2Desc { const bf16_t* Q; long rs; bf16_t* O; float* lse; long lse_rs; int q0; const float* cs; const float* sn; int dil; };
__device__ __forceinline__ void dil_unit2(LAS unsigned char* lds, const Dil2Desc& d) {
    constexpr int KSTR = 144;
    const int tid = threadIdx.x, lane = tid & 63, r32 = lane & 31, hi = lane >> 5;
    const int wid = __builtin_amdgcn_readfirstlane(tid >> 6);
    const int hg = wid >> 2;
    const int a = d.q0 + (wid & 3) * 32, qi = a + r32;
    LAS float* wsf = (LAS float*)(lds + D2_WSF) + wid * 64;
    constexpr float c2 = 0.125f * 1.4426950408889634f;
    bf16x8 qr[4];
    { const bf16_t* qp = d.Q + (long)qi * d.rs + hg * 64 + hi * 8;
      bf16x8 qv[4];
#pragma unroll
      for (int ks = 0; ks < 4; ++ks) qv[ks] = *(const bf16x8*)(qp + ks * 16);
      const float* cq = d.cs + (long)qi * d.dil * 8; const float* sq = d.sn + (long)qi * d.dil * 8;
      const f32x4a cA = *(const f32x4a*)cq, cB = *(const f32x4a*)(cq + 4), sA = *(const f32x4a*)sq, sB = *(const f32x4a*)(sq + 4);
      {
          const u32x4 own = __builtin_bit_cast(u32x4, qv[0]); u32x4 oth;
          oth.x = (unsigned)__shfl_xor((int)own.x, 32); oth.y = (unsigned)__shfl_xor((int)own.y, 32); oth.z = (unsigned)__shfl_xor((int)own.z, 32); oth.w = (unsigned)__shfl_xor((int)own.w, 32);
          const bf16x8 ov = __builtin_bit_cast(bf16x8, oth); const float sg = hi ? 1.0f : -1.0f; bf16x8 t;
#pragma unroll
          for (int e = 0; e < 8; ++e) { const float c = e < 4 ? cA[e & 3] : cB[e & 3], sn_ = e < 4 ? sA[e & 3] : sB[e & 3];
              t[e] = (short)f2bf((bf2f((bf16_t)qv[0][e]) * c + sg * bf2f((bf16_t)ov[e]) * sn_) * c2); }
          qr[0] = t; }
#pragma unroll
      for (int ks = 1; ks < 4; ++ks) { bf16x8 t;
#pragma unroll
          for (int e = 0; e < 8; ++e) t[e] = (short)f2bf(bf2f((bf16_t)qv[ks][e]) * c2);
          qr[ks] = t; } }
    const int j_lo = (d.q0 - 128 > 0 ? d.q0 - 128 : 0) >> 6, j_hi = (d.q0 + 127) >> 6;
    const int wj_lo = (a - 128 > 0 ? a - 128 : 0) >> 6, wj_hi = (a + 31) >> 6;
    const int srow = tid >> 3, c0 = 2 * (tid & 7), shd = c0 >> 3, sc = c0 & 7;
    const bf16_t* kg = d.Q + 1536 + (long)srow * d.rs + c0 * 8; const bf16_t* vg = d.Q + 3072 + (long)srow * d.rs + c0 * 8;
    const int kst = shd * D2_KB + srow * KSTR + sc * 16, vst = shd * VBUF + srow * VSTR + sc * 16;
    u32x4 kr0, kr1, vr0, vr1; f32x4a kcA = {}, kcB = {}, ksA = {}, ksB = {};
    const bool krope = (sc == 0);
#define D2_LOAD(j) do { const bf16_t* kp_ = kg + (long)(j) * 64 * d.rs; const bf16_t* vp_ = vg + (long)(j) * 64 * d.rs; kr0 = *(const u32x4*)kp_; kr1 = *(const u32x4*)(kp_ + 8); vr0 = *(const u32x4*)vp_; vr1 = *(const u32x4*)(vp_ + 8); \
        if (krope) { const long tr_ = (long)((j) * 64 + srow) * d.dil * 8; kcA = *(const f32x4a*)(d.cs + tr_); kcB = *(const f32x4a*)(d.cs + tr_ + 4); ksA = *(const f32x4a*)(d.sn + tr_); ksB = *(const f32x4a*)(d.sn + tr_ + 4); } } while (0)
#define D2_ROPE2(w1, w2, cl, ch, sl, sh) do { const float a1 = __uint_as_float((w1) << 16), b1 = __uint_as_float((w1) & 0xffff0000u), a2 = __uint_as_float((w2) << 16), b2 = __uint_as_float((w2) & 0xffff0000u); \
        (w1) = pk_bf16(a1 * (cl) - a2 * (sl), b1 * (ch) - b2 * (sh)); (w2) = pk_bf16(a2 * (cl) + a1 * (sl), b2 * (ch) + b1 * (sh)); } while (0)
#define D2_STORE(buf) do { if (krope) { D2_ROPE2(kr0.x, kr1.x, kcA[0], kcA[1], ksA[0], ksA[1]); D2_ROPE2(kr0.y, kr1.y, kcA[2], kcA[3], ksA[2], ksA[3]); \
                                        D2_ROPE2(kr0.z, kr1.z, kcB[0], kcB[1], ksB[0], ksB[1]); D2_ROPE2(kr0.w, kr1.w, kcB[2], kcB[3], ksB[2], ksB[3]); } \
        *(LAS u32x4*)(lds + (buf) * 2 * D2_KB + kst) = kr0; *(LAS u32x4*)(lds + (buf) * 2 * D2_KB + kst + 16) = kr1; \
        *(LAS u32x4*)(lds + D2_VOFF + (buf) * 2 * VBUF + vst) = vr0; *(LAS u32x4*)(lds + D2_VOFF + (buf) * 2 * VBUF + vst + 16) = vr1; } while (0)
    float m_run = -INFINITY, l_run = 0.f; f32x16 o0 = {}, o1 = {};
    D2_LOAD(j_lo); D2_STORE(0); __syncthreads();
    const int kro = hg * D2_KB + r32 * KSTR + hi * 16;
    const int vro = hg * VBUF + (4 * hi + ((lane & 15) >> 2)) * VSTR + (16 * ((lane >> 4) & 1) + 4 * (lane & 3)) * 2;
    for (int j = j_lo; j <= j_hi; ++j) {
        const int cur = (j - j_lo) & 1;
        if (j < j_hi) D2_LOAD(j + 1);
        if (j >= wj_lo && j <= wj_hi) {
            const LAS unsigned char* Kb = lds + cur * 2 * D2_KB + kro;
            f32x16 p0 = {}, p1 = {};
#pragma unroll
            for (int ks = 0; ks < 4; ++ks) {
                const bf16x8 k0 = *(const LAS bf16x8*)(Kb + ks * 32), k1 = *(const LAS bf16x8*)(Kb + 32 * KSTR + ks * 32);
                p0 = __builtin_amdgcn_mfma_f32_32x32x16_bf16(k0, qr[ks], p0, 0, 0, 0);
                p1 = __builtin_amdgcn_mfma_f32_32x32x16_bf16(k1, qr[ks], p1, 0, 0, 0);
            }
            if ((64 * j + 63 > a) || (a + 31 - 64 * j > 128)) {
                const int kvb = 64 * j + 4 * hi;
#pragma unroll
                for (int r = 0; r < 16; ++r) { const int kv = kvb + (r & 3) + 8 * (r >> 2); const int d0 = qi - kv, d1 = d0 - 32;
                    if (d0 < 0 || d0 > 128) p0[r] = -INFINITY; if (d1 < 0 || d1 > 128) p1[r] = -INFINITY; }
            }
            float mx = fmaxf(p0[0], p1[0]);
#pragma unroll
            for (int r = 1; r < 16; ++r) mx = fmaxf(fmaxf(mx, p0[r]), p1[r]);
            if (__any(mx > m_run + 8.0f)) {
                mx = fmaxf(mx, xhalf(mx));
                const bool need = mx > m_run + 8.0f;
                const float m_t = need ? mx : m_run;
                const float f = need ? __builtin_amdgcn_exp2f(m_run - m_t) : 1.0f;
                l_run *= f;
                if (hi == 0) wsf[r32] = f;
                asm volatile("s_waitcnt lgkmcnt(0)" ::: "memory");
#pragma unroll
                for (int g = 0; g < 4; ++g) { const f32x4a fv = *(const LAS f32x4a*)(wsf + 8 * g + 4 * hi);
                    o0[4 * g + 0] *= fv.x; o0[4 * g + 1] *= fv.y; o0[4 * g + 2] *= fv.z; o0[4 * g + 3] *= fv.w;
                    o1[4 * g + 0] *= fv.x; o1[4 * g + 1] *= fv.y; o1[4 * g + 2] *= fv.z; o1[4 * g + 3] *= fv.w; }
                m_run = m_t;
            }
            const float m_use = (m_run == -INFINITY) ? 0.f : m_run;
            float ls = 0.f;
#pragma unroll
            for (int r = 0; r < 16; ++r) { p0[r] = __builtin_amdgcn_exp2f(p0[r] - m_use); p1[r] = __builtin_amdgcn_exp2f(p1[r] - m_use); ls += p0[r] + p1[r]; }
            l_run += ls;
            bf16x8 pa[4];
#pragma unroll
            for (int s = 0; s < 2; ++s) {
                u32x4 w0, w1;
                w0.x = pk_bf16(p0[8 * s + 0], p0[8 * s + 1]); w0.y = pk_bf16(p0[8 * s + 2], p0[8 * s + 3]); w0.z = pk_bf16(p0[8 * s + 4], p0[8 * s + 5]); w0.w = pk_bf16(p0[8 * s + 6], p0[8 * s + 7]);
                w1.x = pk_bf16(p1[8 * s + 0], p1[8 * s + 1]); w1.y = pk_bf16(p1[8 * s + 2], p1[8 * s + 3]); w1.z = pk_bf16(p1[8 * s + 4], p1[8 * s + 5]); w1.w = pk_bf16(p1[8 * s + 6], p1[8 * s + 7]);
                pa[s] = __builtin_bit_cast(bf16x8, w0); pa[2 + s] = __builtin_bit_cast(bf16x8, w1);
            }
            mla_pv(lds + D2_VOFF + cur * 2 * VBUF + vro, pa, o0, o1);
        }
        if (j < j_hi) D2_STORE(cur ^ 1);
        __syncthreads();
    }
#undef D2_LOAD
#undef D2_STORE
#undef D2_ROPE2
    const float l_tot = l_run + xhalf(l_run);
    if (hi == 0) wsf[r32] = __builtin_amdgcn_rcpf(l_tot);
    asm volatile("s_waitcnt lgkmcnt(0)" ::: "memory");
    if (hi == 0) d.lse[(long)qi * d.lse_rs + hg] = (m_run + __builtin_amdgcn_logf(l_tot)) * 0.6931471805599453f;
#pragma unroll
    for (int r = 0; r < 16; ++r) {
        const int row = crow(r, hi); const float inv = wsf[row];
        bf16_t* op = d.O + (long)(a + row) * d.rs + hg * 64 + r32;
        op[0] = f2bf(o0[r] * inv); op[32] = f2bf(o1[r] * inv);
    }
    __syncthreads();
}

__device__ __forceinline__ void dil_unit3(LAS unsigned char* lds, const Dil2Desc& d) {
    constexpr int KSTR = 144;
    const int tid = threadIdx.x, lane = tid & 63, r32 = lane & 31, hi = lane >> 5;
    const int wid = __builtin_amdgcn_readfirstlane(tid >> 6);
    const int a = d.q0 + wid * 32, qi = a + r32;
    LAS float* wsf = (LAS float*)(lds + D2_WSF) + wid * 64;
    constexpr float c2 = 0.125f * 1.4426950408889634f;
    bf16x8 qr[4];
    LAS unsigned char* Qs = lds + D2_LDS + wid * 4096 + lane * 16;
    { const float* cq = d.cs + (long)qi * d.dil * 8; const float* sq = d.sn + (long)qi * d.dil * 8;
      const f32x4a cA = *(const f32x4a*)cq, cB = *(const f32x4a*)(cq + 4), sA = *(const f32x4a*)sq, sB = *(const f32x4a*)(sq + 4);
      const float sg = hi ? 1.0f : -1.0f;
#pragma unroll
      for (int hg = 0; hg < 2; ++hg) {
          const bf16_t* qp = d.Q + (long)qi * d.rs + hg * 64 + hi * 8;
          bf16x8 qv[4];
#pragma unroll
          for (int ks = 0; ks < 4; ++ks) qv[ks] = *(const bf16x8*)(qp + ks * 16);
          const u32x4 own = __builtin_bit_cast(u32x4, qv[0]); u32x4 oth;
          oth.x = (unsigned)__shfl_xor((int)own.x, 32); oth.y = (unsigned)__shfl_xor((int)own.y, 32); oth.z = (unsigned)__shfl_xor((int)own.z, 32); oth.w = (unsigned)__shfl_xor((int)own.w, 32);
          const bf16x8 ov = __builtin_bit_cast(bf16x8, oth); bf16x8 t;
#pragma unroll
          for (int e = 0; e < 8; ++e) { const float c = e < 4 ? cA[e & 3] : cB[e & 3], sn_ = e < 4 ? sA[e & 3] : sB[e & 3];
              t[e] = (short)f2bf((bf2f((bf16_t)qv[0][e]) * c + sg * bf2f((bf16_t)ov[e]) * sn_) * c2); }
          if (hg == 0) qr[0] = t; else *(LAS bf16x8*)(Qs) = t;
#pragma unroll
          for (int ks = 1; ks < 4; ++ks) { bf16x8 t2;
#pragma unroll
              for (int e = 0; e < 8; ++e) t2[e] = (short)f2bf(bf2f((bf16_t)qv[ks][e]) * c2);
              if (hg == 0) qr[ks] = t2; else *(LAS bf16x8*)(Qs + ks * 1024) = t2; } } }
    const int j_lo = (d.q0 - 128 > 0 ? d.q0 - 128 : 0) >> 6, j_hi = (d.q0 + 255) >> 6;
    const int wj_lo = (a - 128 > 0 ? a - 128 : 0) >> 6, wj_hi = (a + 31) >> 6;
    const int srow = tid >> 3, c0 = 2 * (tid & 7), shd = c0 >> 3, sc = c0 & 7;
    const bf16_t* kg = d.Q + 1536 + (long)srow * d.rs + c0 * 8; const bf16_t* vg = d.Q + 3072 + (long)srow * d.rs + c0 * 8;
    const int kst = shd * D2_KB + srow * KSTR + sc * 16, vst = shd * VBUF + srow * VSTR + sc * 16;
    u32x4 kr0, kr1, vr0, vr1; f32x4a kcA = {}, kcB = {}, ksA = {}, ksB = {};
    const bool krope = (sc == 0);
#define D3_LOAD(j) do { const bf16_t* kp_ = kg + (long)(j) * 64 * d.rs; const bf16_t* vp_ = vg + (long)(j) * 64 * d.rs; kr0 = *(const u32x4*)kp_; kr1 = *(const u32x4*)(kp_ + 8); vr0 = *(const u32x4*)vp_; vr1 = *(const u32x4*)(vp_ + 8); \
        if (krope) { const long tr_ = (long)((j) * 64 + srow) * d.dil * 8; kcA = *(const f32x4a*)(d.cs + tr_); kcB = *(const f32x4a*)(d.cs + tr_ + 4); ksA = *(const f32x4a*)(d.sn + tr_); ksB = *(const f32x4a*)(d.sn + tr_ + 4); } } while (0)
#define D3_ROPE2(w1, w2, cl, ch, sl, sh) do { const float a1 = __uint_as_float((w1) << 16), b1 = __uint_as_float((w1) & 0xffff0000u), a2 = __uint_as_float((w2) << 16), b2 = __uint_as_float((w2) & 0xffff0000u); \
        (w1) = pk_bf16(a1 * (cl) - a2 * (sl), b1 * (ch) - b2 * (sh)); (w2) = pk_bf16(a2 * (cl) + a1 * (sl), b2 * (ch) + b1 * (sh)); } while (0)
#define D3_STORE(buf) do { if (krope) { D3_ROPE2(kr0.x, kr1.x, kcA[0], kcA[1], ksA[0], ksA[1]); D3_ROPE2(kr0.y, kr1.y, kcA[2], kcA[3], ksA[2], ksA[3]); \
                                        D3_ROPE2(kr0.z, kr1.z, kcB[0], kcB[1], ksB[0], ksB[1]); D3_ROPE2(kr0.w, kr1.w, kcB[2], kcB[3], ksB[2], ksB[3]); } \
        *(LAS u32x4*)(lds + (buf) * 2 * D2_KB + kst) = kr0; *(LAS u32x4*)(lds + (buf) * 2 * D2_KB + kst + 16) = kr1; \
        *(LAS u32x4*)(lds + D2_VOFF + (buf) * 2 * VBUF + vst) = vr0; *(LAS u32x4*)(lds + D2_VOFF + (buf) * 2 * VBUF + vst + 16) = vr1; } while (0)
    float m_run[2] = {-INFINITY, -INFINITY}, l_run[2] = {0.f, 0.f}; f32x16 o[2][2] = {};
    D3_LOAD(j_lo); D3_STORE(0); __syncthreads();
    const int kro = r32 * KSTR + hi * 16;
    const int vro = (4 * hi + ((lane & 15) >> 2)) * VSTR + (16 * ((lane >> 4) & 1) + 4 * (lane & 3)) * 2;
    for (int j = j_lo; j <= j_hi; ++j) {
        const int cur = (j - j_lo) & 1;
        if (j < j_hi) D3_LOAD(j + 1);
        if (j >= wj_lo && j <= wj_hi) {
            f32x16 pp[2][2] = {};
#pragma unroll
            for (int hg = 0; hg < 2; ++hg) {
                const LAS unsigned char* Kb = lds + cur * 2 * D2_KB + hg * D2_KB + kro;
#pragma unroll
                for (int ks = 0; ks < 4; ++ks) {
                    const bf16x8 k0 = *(const LAS bf16x8*)(Kb + ks * 32), k1 = *(const LAS bf16x8*)(Kb + 32 * KSTR + ks * 32);
                    const bf16x8 qf = hg == 0 ? qr[ks] : *(const LAS bf16x8*)(Qs + ks * 1024);
                    pp[hg][0] = __builtin_amdgcn_mfma_f32_32x32x16_bf16(k0, qf, pp[hg][0], 0, 0, 0);
                    pp[hg][1] = __builtin_amdgcn_mfma_f32_32x32x16_bf16(k1, qf, pp[hg][1], 0, 0, 0);
                } }
#pragma unroll
            for (int hg = 0; hg < 2; ++hg) {
                f32x16& p0 = pp[hg][0]; f32x16& p1 = pp[hg][1]; f32x16& o0 = o[hg][0]; f32x16& o1 = o[hg][1];
                {
                    const int t0 = qi - (64 * j + 4 * hi);
                    if (64 * j + 63 > a) {
#pragma unroll
                        for (int r = 0; r < 16; ++r) { const int off = (r & 3) + 8 * (r >> 2); if (off > t0) p0[r] = -INFINITY; if (off + 32 > t0) p1[r] = -INFINITY; } }
                    if (a + 31 - 64 * j > 128) { const int t1 = t0 - 128;
#pragma unroll
                        for (int r = 0; r < 16; ++r) { const int off = (r & 3) + 8 * (r >> 2); if (off < t1) p0[r] = -INFINITY; if (off + 32 < t1) p1[r] = -INFINITY; } }
                }
                float mx = fmaxf(p0[0], p1[0]);
#pragma unroll
                for (int r = 1; r < 16; ++r) mx = fmaxf(fmaxf(mx, p0[r]), p1[r]);
                if (__any(mx > m_run[hg] + 8.0f)) {
                    mx = fmaxf(mx, xhalf(mx));
                    const bool need = mx > m_run[hg] + 8.0f;
                    const float m_t = need ? mx : m_run[hg];
                    const float f = need ? __builtin_amdgcn_exp2f(m_run[hg] - m_t) : 1.0f;
                    l_run[hg] *= f;
                    if (hi == 0) wsf[r32] = f;
                    asm volatile("s_waitcnt lgkmcnt(0)" ::: "memory");
#pragma unroll
                    for (int g = 0; g < 4; ++g) { const f32x4a fv = *(const LAS f32x4a*)(wsf + 8 * g + 4 * hi);
                        o0[4 * g + 0] *= fv.x; o0[4 * g + 1] *= fv.y; o0[4 * g + 2] *= fv.z; o0[4 * g + 3] *= fv.w;
                        o1[4 * g + 0] *= fv.x; o1[4 * g + 1] *= fv.y; o1[4 * g + 2] *= fv.z; o1[4 * g + 3] *= fv.w; }
                    asm volatile("s_waitcnt lgkmcnt(0)" ::: "memory");
                    m_run[hg] = m_t;
                }
                const float m_use = (m_run[hg] == -INFINITY) ? 0.f : m_run[hg];
                float ls = 0.f;
#pragma unroll
                for (int r = 0; r < 16; ++r) { p0[r] = __builtin_amdgcn_exp2f(p0[r] - m_use); p1[r] = __builtin_amdgcn_exp2f(p1[r] - m_use); ls += p0[r] + p1[r]; }
                l_run[hg] += ls;
                bf16x8 pa[4];
#pragma unroll
                for (int s2 = 0; s2 < 2; ++s2) {
                    u32x4 w0, w1;
                    w0.x = pk_bf16(p0[8 * s2 + 0], p0[8 * s2 + 1]); w0.y = pk_bf16(p0[8 * s2 + 2], p0[8 * s2 + 3]); w0.z = pk_bf16(p0[8 * s2 + 4], p0[8 * s2 + 5]); w0.w = pk_bf16(p0[8 * s2 + 6], p0[8 * s2 + 7]);
                    w1.x = pk_bf16(p1[8 * s2 + 0], p1[8 * s2 + 1]); w1.y = pk_bf16(p1[8 * s2 + 2], p1[8 * s2 + 3]); w1.z = pk_bf16(p1[8 * s2 + 4], p1[8 * s2 + 5]); w1.w = pk_bf16(p1[8 * s2 + 6], p1[8 * s2 + 7]);
                    pa[s2] = __builtin_bit_cast(bf16x8, w0); pa[2 + s2] = __builtin_bit_cast(bf16x8, w1);
                }
                mla_pv(lds + D2_VOFF + cur * 2 * VBUF + hg * VBUF + vro, pa, o0, o1);
            }
        }
        if (j < j_hi) D3_STORE(cur ^ 1);
        __syncthreads();
    }
#undef D3_LOAD
#undef D3_STORE
#undef D3_ROPE2
    LAS unsigned char* stg = lds + wid * 9216;
#pragma unroll
    for (int hg = 0; hg < 2; ++hg) {
        const float l_tot = l_run[hg] + xhalf(l_run[hg]);
        if (hi == 0) wsf[r32] = __builtin_amdgcn_rcpf(l_tot);
        asm volatile("s_waitcnt lgkmcnt(0)" ::: "memory");
        if (hi == 0) d.lse[(long)qi * d.lse_rs + hg] = (m_run[hg] + __builtin_amdgcn_logf(l_tot)) * 0.6931471805599453f;
#pragma unroll
        for (int r = 0; r < 16; ++r) {
            const int row = crow(r, hi); const float inv = wsf[row];
            LAS bf16_t* sp = (LAS bf16_t*)(stg + row * 272) + hg * 64 + r32;
            sp[0] = f2bf(o[hg][0][r] * inv); sp[32] = f2bf(o[hg][1][r] * inv);
        }
        asm volatile("s_waitcnt lgkmcnt(0)" ::: "memory");
    }
#pragma unroll
    for (int it = 0; it < 8; ++it) {
        const int row = it * 4 + (lane >> 4), ch = lane & 15;
        const u32x4 v = *(const LAS u32x4*)(stg + row * 272 + ch * 16);
        *(u32x4*)(d.O + (long)(a + row) * d.rs + ch * 8) = v;
    }
    __syncthreads();
}
#undef LAS
}

#define LAS __attribute__((address_space(3)))
typedef unsigned short bf16_t;
typedef unsigned v4u __attribute__((ext_vector_type(4)));
typedef unsigned v2u __attribute__((ext_vector_type(2)));
typedef float f32x4 __attribute__((ext_vector_type(4)));
constexpr int NB = 8, SEQ = 4096, T = NB * SEQ, DM = 1024;
constexpr int N_IN1 = 6400, N_ALL = 8448;
constexpr float EPS = 1e-6f;
constexpr size_t MiB = 1u << 20;
constexpr size_t WS_WIN = 1 * MiB, WS_WUQ = 18 * MiB, WS_WUKV = 19 * MiB, WS_WPM = 20 * MiB, WS_WPD = 21 * MiB, WS_WOUT = 22 * MiB;
constexpr size_t WS_COSM = 24 * MiB, WS_SINM = 26 * MiB, WS_COSD = 28 * MiB, WS_SIND = 29 * MiB;
constexpr size_t WS_QKVD = 32 * MiB, WS_ZM = 320 * MiB, WS_ZD = 352 * MiB, WS_XN = 384 * MiB;
constexpr size_t WS_CQN = 448 * MiB, WS_CKVN = 472 * MiB, WS_KR = 488 * MiB, WS_LSE = 490 * MiB, WS_END = 512 * MiB;
constexpr size_t WS_GMD = 32 * MiB, WS_MRG = 160 * MiB, WS_Y = 224 * MiB;
constexpr size_t DO_CL = 0, DO_V = 0, DO_Q = 48 * MiB, DO_KN = 96 * MiB;
constexpr int LDS_BYTES = 147456;

struct Args { const float* x; const int* pos; const float* pre_g; const float* w_in; const float* q_g; const float* w_uq; const float* kv_g; const float* w_ukv;
              const float* w_pm; const float* w_pd; const float* w_out; const float* post_g; float* out; unsigned char* ws; int ph_lo, ph_hi; };

__device__ __forceinline__ unsigned f2bf_u(float f) { unsigned u = __builtin_bit_cast(unsigned, f); return (u + 0x7fffu + ((u >> 16) & 1u)) >> 16; }
__device__ __forceinline__ unsigned pk2(float lo, float hi) { return f2bf_u(lo) | (f2bf_u(hi) << 16); }
__device__ __forceinline__ float bflo(unsigned w) { return __uint_as_float(w << 16); }
__device__ __forceinline__ float bfhi(unsigned w) { return __uint_as_float(w & 0xffff0000u); }
__device__ __forceinline__ float wave_sum(float v) {
#pragma unroll
    for (int o = 1; o < 64; o <<= 1) v += __shfl_xor(v, o);
    return v;
}
__device__ __forceinline__ void transpose_item(const float* W, int K, int N, bf16_t* WT, int k0, int sn0, int dn0, LAS float* scr, int lane, const float* gk = nullptr) {
    if (sn0 >= 0) {
#pragma unroll 8
        for (int i = 0; i < 32; ++i) { const int kk = 2 * i + (lane >> 5); scr[kk * 33 + (lane & 31)] = W[(size_t)(k0 + kk) * N + sn0 + (lane & 31)] * (gk ? gk[k0 + kk] : 1.0f); }
    } else {
#pragma unroll 8
        for (int i = 0; i < 32; ++i) { const int kk = 2 * i + (lane >> 5); scr[kk * 33 + (lane & 31)] = 0.f; }
    }
    asm volatile("s_waitcnt lgkmcnt(0)" ::: "memory");
    const int c = lane & 7;
#pragma unroll
    for (int j = 0; j < 4; ++j) { const int n = (lane >> 3) + 8 * j; const LAS float* s = scr + (8 * c) * 33 + n;
        v4u o; o.x = pk2(s[0 * 33], s[1 * 33]); o.y = pk2(s[2 * 33], s[3 * 33]); o.z = pk2(s[4 * 33], s[5 * 33]); o.w = pk2(s[6 * 33], s[7 * 33]);
        *(v4u*)(WT + (size_t)(dn0 + n) * K + k0 + 8 * c) = o; }
    asm volatile("s_waitcnt lgkmcnt(0)" ::: "memory");
}
__device__ __forceinline__ void sincos_rev(float ang, float& c, float& s) {
    const double rev = (double)ang * 0.15915494309189533577; const float fr = (float)(rev - __builtin_rint(rev));
    s = __builtin_amdgcn_sinf(fr); c = __builtin_amdgcn_cosf(fr);
}


#define XB_TMO      128
#define XB_XCNT(j)  (256  + 64 * (j))
#define XB_XSUB(j)  (1280 + 64 * (j))
#define XB_XGEN(j)  (2304 + 64 * (j))
#define XB_TOP      3328
#define XB_TOPGEN   3392
#define XCD_BAR_WORDS 3456
#define XB_SPIN_CAP (1u << 18)

__device__ __forceinline__ unsigned xb_ld(unsigned* p)              { return __hip_atomic_load(p, __ATOMIC_RELAXED, __HIP_MEMORY_SCOPE_AGENT); }
__device__ __forceinline__ unsigned xb_add(unsigned* p, unsigned v) { return __hip_atomic_fetch_add(p, v, __ATOMIC_RELAXED, __HIP_MEMORY_SCOPE_AGENT); }
__device__ __forceinline__ unsigned xb_xcc_id() { return (unsigned)__builtin_amdgcn_s_getreg((3 << 11) | 20) & 0xFu; }
#define XB_SPIN(cond, bar) do { unsigned _sp = 0; while (cond) { __builtin_amdgcn_s_sleep(1); \
    if ((++_sp & 255u) == 0u) { if (xb_ld(&(bar)[XB_TMO])) break; if (_sp > XB_SPIN_CAP) { atomicAdd(&(bar)[XB_TMO], 1u); break; } } } } while (0)

struct XcdBarrier {
    unsigned* bar; unsigned x;
    volatile LAS unsigned* st;
};

__device__ __forceinline__ XcdBarrier xcd_barrier_post(unsigned* bar, volatile LAS unsigned* st) {
    XcdBarrier b; b.bar = bar; b.x = xb_xcc_id(); b.st = st;
    if (threadIdx.x == 0) (void)xb_add(&bar[XB_XCNT(b.x)], 1u);
    return b;
}
__device__ __forceinline__ void xcd_barrier_complete(unsigned* bar, unsigned x, unsigned& nloc, unsigned& nx) {
    const unsigned G = gridDim.x * gridDim.y * gridDim.z;
    unsigned sum, cnt, mine, sp = 0u;
    for (;;) {
        sum = 0u; cnt = 0u; mine = 0u;
#pragma unroll
        for (unsigned j = 0; j < 16; ++j) { const unsigned c = xb_ld(&bar[XB_XCNT(j)]); sum += c; cnt += (c > 0u) ? 1u : 0u; mine = (j == x) ? c : mine; }
        if (sum == G) break;
        __builtin_amdgcn_s_sleep(1);
        if ((++sp & 255u) == 0u) { if (xb_ld(&bar[XB_TMO])) break; if (sp > XB_SPIN_CAP) { atomicAdd(&bar[XB_TMO], 1u); break; } }
    }
    nloc = mine > 0u ? mine : 1u; nx = cnt > 0u ? cnt : 1u;
}

__device__ __forceinline__ void xcd_barrier(const XcdBarrier& b) {
    asm volatile("s_waitcnt vmcnt(0)" ::: "memory");
    __syncthreads();
    if (threadIdx.x == 0) {
        unsigned* bar = b.bar;
        __builtin_amdgcn_s_waitcnt(0);
        unsigned nloc = b.st[0], nx = b.st[1];
        if (nloc == 0u) { xcd_barrier_complete(bar, b.x, nloc, nx); b.st[0] = nloc; b.st[1] = nx; }
        const unsigned old = xb_add(&bar[XB_XSUB(b.x)], 1u);
        const unsigned gen = old / nloc;
        if (old + 1u == (gen + 1u) * nloc) {
            __builtin_amdgcn_fence(__ATOMIC_RELEASE, "agent");
            asm volatile("s_waitcnt vmcnt(0)" ::: "memory");
            const unsigned og = xb_add(&bar[XB_TOP], 1u);
            const unsigned tg = og / nx;
            if (og + 1u == (tg + 1u) * nx) xb_add(&bar[XB_TOPGEN], 1u);
            else XB_SPIN(xb_ld(&bar[XB_TOPGEN]) == tg, bar);
            __builtin_amdgcn_fence(__ATOMIC_ACQUIRE, "agent");
            xb_add(&bar[XB_XGEN(b.x)], 1u);
            asm volatile("s_waitcnt vmcnt(0)" ::: "memory");
        } else {
            XB_SPIN(xb_ld(&bar[XB_XGEN(b.x)]) == gen, bar);
            __builtin_amdgcn_fence(__ATOMIC_ACQUIRE, "agent");
            asm volatile("s_waitcnt vmcnt(0)" ::: "memory");
        }
    }
    __syncthreads();
}

__global__ void __launch_bounds__(512, 2) fwd_kernel(Args A) {
    extern __shared__ __attribute__((aligned(16))) unsigned char lds_raw[];
    LAS unsigned char* lds = (LAS unsigned char*)lds_raw;
#if N_LAUNCH_MODE == 1
    cg::grid_group grid = cg::this_grid();
#endif
    const int tid = threadIdx.x, lane = tid & 63, wave = __builtin_amdgcn_readfirstlane(tid >> 6);
    const int G = gridDim.x, bx = blockIdx.x;
    const int gw = bx * 8 + wave, NGW = G * 8;
    unsigned char* ws = A.ws; unsigned char* dob = (unsigned char*)A.out;
    bf16_t* Win_t = (bf16_t*)(ws + WS_WIN); bf16_t* Wuq_t = (bf16_t*)(ws + WS_WUQ); bf16_t* Wukv_t = (bf16_t*)(ws + WS_WUKV);
    bf16_t* Wpm_t = (bf16_t*)(ws + WS_WPM); bf16_t* Wpd_t = (bf16_t*)(ws + WS_WPD); bf16_t* Wout_t = (bf16_t*)(ws + WS_WOUT);
    float* cosm = (float*)(ws + WS_COSM); float* sinm = (float*)(ws + WS_SINM); float* cosd = (float*)(ws + WS_COSD); float* sind = (float*)(ws + WS_SIND);
    bf16_t* QKVD = (bf16_t*)(ws + WS_QKVD); bf16_t* ZM = (bf16_t*)(ws + WS_ZM); bf16_t* ZD = (bf16_t*)(ws + WS_ZD); bf16_t* XN = (bf16_t*)(ws + WS_XN);
    bf16_t* CQN = (bf16_t*)(ws + WS_CQN); bf16_t* CKVN = (bf16_t*)(ws + WS_CKVN); bf16_t* KR = (bf16_t*)(ws + WS_KR); float* LSE = (float*)(ws + WS_LSE);
    bf16_t* GMD = (bf16_t*)(dob); float* SSQ_Q = (float*)(ws + 65536); float* SSQ_KV = (float*)(ws + 65536 + 131072); bf16_t* MRG = (bf16_t*)(ws + WS_MRG); bf16_t* Y = (bf16_t*)(ws + WS_Y);
    bf16_t* CL = (bf16_t*)(dob + DO_CL); bf16_t* Vb = (bf16_t*)(ws + WS_CQN);     bf16_t* Qb = (bf16_t*)(dob + DO_Q); bf16_t* KN = (bf16_t*)(dob + DO_KN);
    const int lo = A.ph_lo, hi = A.ph_hi;
    volatile LAS unsigned* MISC = (volatile LAS unsigned*)(lds + 131072 + 320);
    if (tid < 32) MISC[tid] = 0u;
    __syncthreads();
    XcdBarrier bar = xcd_barrier_post((unsigned*)(ws + 4096), MISC + 8);
#define IN(k) (lo <= (k) && (k) < hi)
#if N_LAUNCH_MODE == 1
#define SEAM(k) do { if (IN(k) && IN((k) + 1)) { if (lo < 0) grid.sync(); else xcd_barrier(bar); } } while (0)
#else
#define SEAM(k) do { } while (0)
#endif

    if (IN(0)) {
        LAS float* scr = (LAS float*)(lds + wave * 16384);
        constexpr int I_IN = 16 * (N_ALL / 32), I_UQ = 6 * 24, I_UKV = 4 * 32, I_PM = 8 * 32, I_PD = 8 * 32, I_OUT = 16 * 32;
        constexpr int NITEMS = I_IN + I_UQ + I_UKV + I_PM + I_PD + I_OUT;
        for (int it = gw; it < NITEMS; it += NGW) {
            int r = it;
            if (r < I_IN) { const int nblk = N_ALL / 32, kb = r / nblk, nb = r % nblk, n0 = nb * 32;
                const int sn0 = n0 < 5632 ? n0 + 672 : n0 < 6304 ? n0 - 5632 : n0 < 6400 ? -1 : n0 - 96;
                transpose_item(A.w_in, 1024, 8352, Win_t, kb * 64, sn0, n0, scr, lane); continue; } r -= I_IN;
            if (r < I_UQ) { const int kb = r / 24, nb = r % 24; transpose_item(A.w_uq, 384, 768, Wuq_t, kb * 64, nb * 32, nb * 32, scr, lane, A.q_g); continue; } r -= I_UQ;
            if (r < I_UKV) { const int kb = r / 32, nb = r % 32, n0 = nb * 32; const int hh = (n0 & 511) >> 6, sn0 = hh * 128 + (n0 >= 512 ? 64 : 0) + (n0 & 63);
                transpose_item(A.w_ukv, 256, 1024, Wukv_t, kb * 64, sn0, n0, scr, lane, A.kv_g); continue; } r -= I_UKV;
            if (r < I_PM) { const int kb = r / 32, nb = r % 32; transpose_item(A.w_pm, 512, 1024, Wpm_t, kb * 64, nb * 32, nb * 32, scr, lane); continue; } r -= I_PM;
            if (r < I_PD) { const int kb = r / 32, nb = r % 32; transpose_item(A.w_pd, 512, 1024, Wpd_t, kb * 64, nb * 32, nb * 32, scr, lane); continue; } r -= I_PD;
            { const int kb = r / 32, nb = r % 32; transpose_item(A.w_out, 1024, 1024, Wout_t, kb * 64, nb * 32, nb * 32, scr, lane); }
        }
        for (int m0 = gw * 4; m0 < T; m0 += NGW * 4) {
            f32x4 v[4][4]; float s2[4];
#pragma unroll
            for (int r = 0; r < 4; ++r) { const f32x4* xr = (const f32x4*)(A.x + (size_t)(m0 + r) * DM) + lane;
#pragma unroll
                for (int j = 0; j < 4; ++j) v[r][j] = __builtin_nontemporal_load(xr + 64 * j); }
            f32x4 gq[4];
#pragma unroll
            for (int j = 0; j < 4; ++j) gq[j] = ((const f32x4*)A.pre_g)[lane + 64 * j];
#pragma unroll
            for (int r = 0; r < 4; ++r) { float a = 0.f;
#pragma unroll
                for (int j = 0; j < 4; ++j) a += (v[r][j].x * v[r][j].x + v[r][j].y * v[r][j].y) + (v[r][j].z * v[r][j].z + v[r][j].w * v[r][j].w);
                s2[r] = a; }
#pragma unroll
            for (int o = 1; o < 64; o <<= 1) {
#pragma unroll
                for (int r = 0; r < 4; ++r) s2[r] += __shfl_xor(s2[r], o); }
#pragma unroll
            for (int r = 0; r < 4; ++r) { const float rstd = 1.0f / sqrtf(s2[r] * (1.f / DM) + EPS); v2u* o8 = (v2u*)(XN + (size_t)(m0 + r) * DM) + lane;
#pragma unroll
                for (int j = 0; j < 4; ++j) { v2u o; o.x = pk2(v[r][j].x * rstd * gq[j].x, v[r][j].y * rstd * gq[j].y); o.y = pk2(v[r][j].z * rstd * gq[j].z, v[r][j].w * rstd * gq[j].w); o8[64 * j] = o; } }
        }
        for (int e = bx * 512 + tid; e < T * 24; e += G * 512) {
            const int t = e / 24, i = e % 24; const float p = (float)A.pos[t];
            if (i < 16) { const float inv = powf(500000.0f, -(float)(2 * i) / 32.0f); float c, s; sincos_rev(p * inv, c, s); cosm[t * 16 + i] = c; sinm[t * 16 + i] = s; }
            else { const int k = i - 16; const float inv = powf(500000.0f, -(float)(2 * k) / 16.0f); float c, s; sincos_rev(p * inv, c, s); cosd[t * 8 + k] = c; sind[t * 8 + k] = s; }
        }
    }
    SEAM(0);
    if (IN(1)) {
        pg8::Gemm g{XN, Win_t, T, N_IN1, DM}; pg8::StaticOrder S; S.init(T, N_IN1, G, bx);
        pg8::EpiIn E{QKVD, ZM, ZD, CL, SSQ_Q, SSQ_KV};
        pg8::gemm_phase<pg8::EpiIn, pg8::StaticOrder, false, true>(lds, g, S, E);
    }
    SEAM(1);
    if (IN(3)) {
        for (int m = bx * 512 + tid; m < T * 16; m += G * 512) { const int t = m >> 4, i = m & 15; const bf16_t* cl = CL + (size_t)t * 768;
            const float x1 = att::bf2f(cl[640 + i]), x2 = att::bf2f(cl[656 + i]), c = cosm[(size_t)t * 16 + i], sn_ = sinm[(size_t)t * 16 + i];
            KR[(size_t)t * 32 + i] = (bf16_t)f2bf_u(x1 * c - x2 * sn_); KR[(size_t)t * 32 + 16 + i] = (bf16_t)f2bf_u(x2 * c + x1 * sn_); }
        { pg8::Gemm g{CL, Wuq_t, T, 768, 384, 768}; pg8::StaticOrder S; S.init(T, 768, G, bx); pg8::EpiScaleStore E{Qb, 768, 1 << 20, Qb, 768, SSQ_Q, 1.0f / 384.0f};
          pg8::gemm_phase<pg8::EpiScaleStore, pg8::StaticOrder, true, true>(lds, g, S, E); }
        { pg8::Gemm g{CL + 384, Wukv_t, T, 1024, 256, 768}; pg8::StaticOrder S; S.init(T, 1024, G, bx); pg8::EpiScaleStore E{KN, 512, 2, Vb, 512, SSQ_KV, 1.0f / 256.0f};
          pg8::gemm_phase<pg8::EpiScaleStore, pg8::StaticOrder, true, true>(lds, g, S, E); }
    }
    SEAM(3);
    if (IN(4)) {
        if (wave >= 4) __builtin_amdgcn_s_setprio(1);
#if !DEBUG_NAIVE_MLA
        for (int rd = 0; ; ++rd) {
            const int it = rd * G + ((rd & 1) ? (G - 1 - bx) : bx);
            if (rd * G >= 1024) break;
            if (it >= 1024) continue;
            const int qb = 15 - (it >> 6), bh = it & 63, b = bh >> 3, h = bh & 7;
            att::UnitDesc d;
            d.Q = Qb + (size_t)b * SEQ * 768 + h * 96; d.q_rs = 768; d.K = KN + (size_t)b * SEQ * 512 + h * 64; d.k_rs = 512; d.K2 = KR + (size_t)b * SEQ * 32; d.k2_rs = 32;
            d.V = Vb + (size_t)b * SEQ * 512 + h * 64; d.v_rs = 512; d.cs = cosm + (size_t)b * SEQ * 16; d.sn = sinm + (size_t)b * SEQ * 16;
            d.O = ZM + (size_t)b * SEQ * 512 + h * 64; d.o_rs = 512; d.lse = nullptr; d.lse_rs = 0; d.q0 = qb * 256; d.W = 1 << 30; d.c2 = 0.10206207261596577f * 1.4426950408889634f;
            att::mla_unit(lds, d);
        }
#endif
#if !DEBUG_NAIVE_DIL
        const int vcu = (G % 8 == 0) ? (bx % 8) * (G / 8) + bx / 8 : bx;
        for (int it = vcu; it < 1536; it += G) {
            const int bhp = it / 48, rem = it % 48, g = rem >> 4, idx = rem & 15, b = bhp >> 2, hp = bhp & 3;
            const int dil = g == 0 ? 1 : g == 1 ? 4 : 16, nqb = 16 / dil, rs = idx / nqb, qb = idx % nqb;
            att::Dil2Desc d;
            bf16_t* base = QKVD + ((size_t)b * SEQ + rs) * 4608 + g * 512 + hp * 128;
            d.Q = base; d.rs = (long)dil * 4608; d.O = base;
            d.lse = LSE + (size_t)g * T * 8 + ((size_t)b * SEQ + rs) * 8 + hp * 2; d.lse_rs = (long)dil * 8; d.q0 = qb * 256;
            d.cs = cosd + ((size_t)b * SEQ + rs) * 8; d.sn = sind + ((size_t)b * SEQ + rs) * 8; d.dil = dil;
            att::dil_unit3(lds, d);
        }
#endif
    }
    if (IN(4)) __builtin_amdgcn_s_setprio(0);
    SEAM(4);
    if (IN(5)) {
        const int hh = lane >> 3;
        for (int m0 = gw * 4; m0 < T; m0 += NGW * 4) {
            float l0[4], l1[4], l2[4]; v4u x0[4], x1[4], x2[4], zz[4];
#pragma unroll
            for (int r = 0; r < 4; ++r) { const size_t m = (size_t)(m0 + r);
                l0[r] = LSE[m * 8 + hh]; l1[r] = LSE[(size_t)T * 8 + m * 8 + hh]; l2[r] = LSE[(size_t)2 * T * 8 + m * 8 + hh];
                const bf16_t* o = QKVD + m * 4608 + lane * 8; x0[r] = *(const v4u*)o; x1[r] = *(const v4u*)(o + 512); x2[r] = *(const v4u*)(o + 1024);
                zz[r] = *(const v4u*)(ZD + m * 512 + lane * 8); }
#pragma unroll
            for (int r = 0; r < 4; ++r) {
                const float mx = fmaxf(l0[r], fmaxf(l1[r], l2[r])); float a0 = __expf(l0[r] - mx), a1 = __expf(l1[r] - mx), a2 = __expf(l2[r] - mx); const float inv = 1.0f / (a0 + a1 + a2); a0 *= inv; a1 *= inv; a2 *= inv;
                const v4u z = zz[r]; v4u rr;
#define CMB(c) rr.c = pk2((a0 * bflo(x0[r].c) + a1 * bflo(x1[r].c) + a2 * bflo(x2[r].c)) * bflo(z.c), (a0 * bfhi(x0[r].c) + a1 * bfhi(x1[r].c) + a2 * bfhi(x2[r].c)) * bfhi(z.c))
                CMB(x); CMB(y); CMB(z); CMB(w);
#undef CMB
                *(v4u*)(ZD + (size_t)(m0 + r) * 512 + lane * 8) = rr; }
        }
    }
    __syncthreads();
    if (IN(6)) {
        pg8::Gemm g{XN, Win_t + (size_t)N_IN1 * DM, T, 2048, DM}; pg8::StaticOrder S; S.init(T, 2048, G, bx); pg8::EpiSig E{GMD, 2048};
        pg8::gemm_phase<pg8::EpiSig, pg8::StaticOrder, false, true>(lds, g, S, E);
    }
    SEAM(6);
    if (IN(7)) {
        pg8::StaticOrder S; S.init(T, 1024, G, bx);
        { pg8::Gemm g{ZM, Wpm_t, T, 1024, 512}; pg8::EpiGate<false> E{MRG, 1024, GMD, 2048, 0};
          pg8::gemm_phase<pg8::EpiGate<false>, pg8::StaticOrder, true, true>(lds, g, S, E); }
        { pg8::Gemm g{ZD, Wpd_t, T, 1024, 512}; pg8::EpiGate<true> E{MRG, 1024, GMD, 2048, 1024};
          pg8::gemm_phase<pg8::EpiGate<true>, pg8::StaticOrder, true, true>(lds, g, S, E); }
    }
    SEAM(7);
    if (IN(8)) {
        pg8::Gemm g{MRG, Wout_t, T, 1024, DM}; pg8::StaticOrder S; S.init(T, 1024, G, bx); pg8::EpiStore E{Y, 1024, 1 << 20, Y, 1024};
        pg8::gemm_phase<pg8::EpiStore, pg8::StaticOrder, true, true>(lds, g, S, E);
    }
    SEAM(8);
    if (IN(9)) {
        float dbgC = 0.f, dbgB = 0.f;
        for (int m0 = gw * 2; m0 < T; m0 += NGW * 2) {
            v4u w[2][2]; f32x4 xa[2][2], xb[2][2]; float s2[2];
#pragma unroll
            for (int r = 0; r < 2; ++r) { const v4u* yr = (const v4u*)(Y + (size_t)(m0 + r) * DM);
#pragma unroll
                for (int j = 0; j < 2; ++j) { w[r][j] = yr[lane + 64 * j]; const f32x4* xp = (const f32x4*)(A.x + (size_t)(m0 + r) * DM + (lane + 64 * j) * 8); xa[r][j] = __builtin_nontemporal_load(xp); xb[r][j] = __builtin_nontemporal_load(xp + 1); } }
#pragma unroll
            for (int r = 0; r < 2; ++r) { float a = 0.f;
#pragma unroll
                for (int j = 0; j < 2; ++j) a += bflo(w[r][j].x) * bflo(w[r][j].x) + bfhi(w[r][j].x) * bfhi(w[r][j].x) + bflo(w[r][j].y) * bflo(w[r][j].y) + bfhi(w[r][j].y) * bfhi(w[r][j].y)
                    + bflo(w[r][j].z) * bflo(w[r][j].z) + bfhi(w[r][j].z) * bfhi(w[r][j].z) + bflo(w[r][j].w) * bflo(w[r][j].w) + bfhi(w[r][j].w) * bfhi(w[r][j].w);
                s2[r] = a; }
#pragma unroll
            for (int o = 1; o < 64; o <<= 1) { s2[0] += __shfl_xor(s2[0], o); s2[1] += __shfl_xor(s2[1], o); }
#pragma unroll
            for (int r = 0; r < 2; ++r) { const float rstd = 1.0f / sqrtf(s2[r] * (1.f / DM) + EPS);
#pragma unroll
                for (int j = 0; j < 2; ++j) { const int c = (lane + 64 * j) * 8; const f32x4* gp = (const f32x4*)(A.post_g + c); f32x4* op = (f32x4*)(A.out + (size_t)(m0 + r) * DM + c);
                    const f32x4 ga = gp[0], gb = gp[1]; f32x4 oa, ob; const v4u ww = w[r][j];
                    oa.x = xa[r][j].x + bflo(ww.x) * rstd * ga.x; oa.y = xa[r][j].y + bfhi(ww.x) * rstd * ga.y; oa.z = xa[r][j].z + bflo(ww.y) * rstd * ga.z; oa.w = xa[r][j].w + bfhi(ww.y) * rstd * ga.w;
                    ob.x = xb[r][j].x + bflo(ww.z) * rstd * gb.x; ob.y = xb[r][j].y + bfhi(ww.z) * rstd * gb.y; ob.z = xb[r][j].z + bflo(ww.w) * rstd * gb.z; ob.w = xb[r][j].w + bfhi(ww.w) * rstd * gb.w;
                    __builtin_nontemporal_store(oa, op); __builtin_nontemporal_store(ob, op + 1); } }
        }
    }
#undef IN
#undef SEAM
}


#if DEBUG_NAIVE_MLA
__global__ void __launch_bounds__(256) naive_mla(Args A) {
    unsigned char* ws = A.ws; unsigned char* dob = (unsigned char*)A.out;
    const float* cosm = (const float*)(ws + WS_COSM); const float* sinm = (const float*)(ws + WS_SINM);
    bf16_t* ZM = (bf16_t*)(ws + WS_ZM); const bf16_t* KR = (const bf16_t*)(ws + WS_KR);
    const bf16_t* Vb = (const bf16_t*)(dob + DO_V); const bf16_t* Qb = (const bf16_t*)(dob + DO_Q); const bf16_t* KN = (const bf16_t*)(dob + DO_KN);
    const int gid = blockIdx.x * 256 + threadIdx.x;
    const int tq = gid & 4095, h = (gid >> 12) & 7, b = gid >> 15;
    const size_t row = (size_t)b * SEQ + tq;
    float q[96];
#pragma unroll
    for (int d = 0; d < 96; ++d) q[d] = att::bf2f(Qb[row * 768 + h * 96 + d]);
#pragma unroll
    for (int i = 0; i < 16; ++i) { const float c = cosm[row * 16 + i], s = sinm[row * 16 + i], x1 = q[64 + i], x2 = q[80 + i];
        q[64 + i] = att::bf2f(att::f2bf(x1 * c - x2 * s)); q[80 + i] = att::bf2f(att::f2bf(x2 * c + x1 * s)); }
    float o[64];
#pragma unroll
    for (int d = 0; d < 64; ++d) o[d] = 0.f;
    float m = -INFINITY, l = 0.f;
    const int kmax = (tq | 63);
    for (int k = 0; k <= kmax; ++k) {
        const size_t kr = (size_t)b * SEQ + k; float s = 0.f;
#pragma unroll
        for (int d = 0; d < 64; ++d) s += q[d] * att::bf2f(KN[kr * 512 + h * 64 + d]);
#pragma unroll
        for (int d = 0; d < 32; ++d) s += q[64 + d] * att::bf2f(KR[kr * 32 + d]);
        s *= 0.10206207261596577f;
        if (k <= tq) {
            const float mn = fmaxf(m, s), f = __expf(m - mn), p = __expf(s - mn);
            l = l * f + p;
#pragma unroll
            for (int d = 0; d < 64; ++d) o[d] = o[d] * f + p * att::bf2f(Vb[kr * 512 + h * 64 + d]);
            m = mn;
        }
    }
    const float inv = 1.f / l;
#pragma unroll
    for (int d = 0; d < 64; ++d) { bf16_t* op = ZM + row * 512 + h * 64 + d; *op = att::f2bf(o[d] * inv * att::bf2f(*op)); }
}
#endif
#if DEBUG_NAIVE_DIL
__global__ void __launch_bounds__(256) naive_dil(Args A) {
    unsigned char* ws = A.ws;
    bf16_t* QKVD = (bf16_t*)(ws + WS_QKVD); float* LSE = (float*)(ws + WS_LSE);
    const int gid = blockIdx.x * 256 + threadIdx.x;
    const int t = gid & 4095, h = (gid >> 12) & 7, g = (gid >> 15) % 3, b = gid / (3 * 32768);
    const int dil = g == 0 ? 1 : g == 1 ? 4 : 16;
    const size_t row = (size_t)b * SEQ + t;
    bf16_t* qp = QKVD + row * 4608 + g * 512 + h * 64;
    float q[64], o[64];
#pragma unroll
    for (int d = 0; d < 64; ++d) { q[d] = att::bf2f(qp[d]); o[d] = 0.f; }
    float m = -INFINITY, l = 0.f;
    const int mi = t / dil;
    for (int i = 0; i <= 128; ++i) {
        if (mi - i < 0) break;
        const size_t kr = row - (size_t)i * dil; const bf16_t* kp = QKVD + kr * 4608 + 1536 + g * 512 + h * 64; float s = 0.f;
#pragma unroll
        for (int d = 0; d < 64; ++d) s += q[d] * att::bf2f(kp[d]);
        s *= 0.125f;
        const float mn = fmaxf(m, s), f = __expf(m - mn), p = __expf(s - mn);
        l = l * f + p;
#pragma unroll
        for (int d = 0; d < 64; ++d) o[d] = o[d] * f + p * att::bf2f(kp[1536 + d]);
        m = mn;
    }
    const float inv = 1.f / l;
    __syncthreads();
#pragma unroll
    for (int d = 0; d < 64; ++d) qp[d] = att::f2bf(o[d] * inv);
    LSE[(size_t)g * T * 8 + row * 8 + h] = m + __logf(l);
}
#endif

#if DEBUG_CHECK
template <int MODE> __global__ void __launch_bounds__(256) check_kernel(Args A) {
    unsigned char* ws = A.ws; unsigned char* dob = (unsigned char*)A.out; unsigned* flags = (unsigned*)ws;
    const bf16_t* QKVD = (const bf16_t*)(ws + WS_QKVD); const bf16_t* ZM = (const bf16_t*)(ws + WS_ZM); const bf16_t* ZD = (const bf16_t*)(ws + WS_ZD); const bf16_t* XN = (const bf16_t*)(ws + WS_XN);
    const bf16_t* CQN = (const bf16_t*)(ws + WS_CQN); const bf16_t* CKVN = (const bf16_t*)(ws + WS_CKVN);
    const bf16_t* MRG = (const bf16_t*)(ws + WS_MRG); const bf16_t* Y = (const bf16_t*)(ws + WS_Y);
    const bf16_t* CL = (const bf16_t*)(dob + DO_CL); const bf16_t* Vb = (const bf16_t*)(dob + DO_V); const bf16_t* Qb = (const bf16_t*)(dob + DO_Q); const bf16_t* KN = (const bf16_t*)(dob + DO_KN);
    const float* cosm = (const float*)(ws + WS_COSM); const float* sinm = (const float*)(ws + WS_SINM); const float* cosd = (const float*)(ws + WS_COSD); const float* sind = (const float*)(ws + WS_SIND);
    const unsigned idx0 = blockIdx.x * 256 + threadIdx.x;
    unsigned hsh = idx0 * 2654435761u; hsh ^= hsh >> 15; hsh *= 2246822519u; hsh ^= hsh >> 13; hsh *= 3266489917u; hsh ^= hsh >> 16;
    const unsigned idx = hsh >> 7;
    const size_t row = (hsh * 2654435761u >> 9) % (unsigned)T;
    float got = 0.f, ref = 0.f; unsigned bit = 0;
    if (MODE == 1) { const int n = (idx * 40503u + 17u) % 6304u; float acc = 0.f;
        for (int k = 0; k < 1024; ++k) acc += att::bf2f(XN[row * 1024 + k]) * A.w_in[(size_t)k * 8352 + n];
        if (n < 672) { got = att::bf2f(CL[row * 768 + n]); ref = acc; } else if (n < 5280) { got = att::bf2f(QKVD[row * 4608 + n - 672]); ref = acc; }
        else if (n < 5792) { got = att::bf2f(ZM[row * 512 + n - 5280]); ref = pg8::silu_f(acc); } else { got = att::bf2f(ZD[row * 512 + n - 5792]); ref = pg8::silu_f(acc); }
        bit = 1u; }
    if (MODE == 2) { const int n = (idx * 40503u + 17u) % 1792u; float acc = 0.f;
        if (n < 768) { for (int k = 0; k < 384; ++k) acc += att::bf2f(CQN[row * 384 + k]) * A.w_uq[(size_t)k * 768 + n]; got = att::bf2f(Qb[row * 768 + n]); }
        else { const int c = n - 768, hh = c >> 7, w = c & 127; for (int k = 0; k < 256; ++k) acc += att::bf2f(CKVN[row * 256 + k]) * A.w_ukv[(size_t)k * 1024 + c];
            got = w < 64 ? att::bf2f(KN[row * 512 + hh * 64 + w]) : att::bf2f(Vb[row * 512 + hh * 64 + w - 64]); }
        ref = acc; bit = 2u; }
    if (MODE == 3) { const int n = (idx * 40503u + 17u) % 1024u; float g1 = 0.f, g2 = 0.f, y1 = 0.f, y2 = 0.f;
        for (int k = 0; k < 1024; ++k) { const float xv = att::bf2f(XN[row * 1024 + k]); g1 += xv * A.w_in[(size_t)k * 8352 + 6304 + n]; g2 += xv * A.w_in[(size_t)k * 8352 + 7328 + n]; }
        for (int k = 0; k < 512; ++k) { y1 += att::bf2f(ZM[row * 512 + k]) * A.w_pm[(size_t)k * 1024 + n]; y2 += att::bf2f(ZD[row * 512 + k]) * A.w_pd[(size_t)k * 1024 + n]; }
        ref = pg8::sigm_f(g1) * y1 + pg8::sigm_f(g2) * y2; got = att::bf2f(MRG[row * 1024 + n]); bit = 4u; }
    if (MODE == 4) { const int n = (idx * 40503u + 17u) % 1024u; float acc = 0.f;
        for (int k = 0; k < 1024; ++k) acc += att::bf2f(MRG[row * 1024 + k]) * A.w_out[(size_t)k * 1024 + n];
        ref = acc; got = att::bf2f(Y[row * 1024 + n]); bit = 8u; }
    if (MODE == 6) { const int n = (idx * 40503u + 17u) % 2048u; float g1 = 0.f; const bf16_t* GMD = (const bf16_t*)(dob);
        for (int k = 0; k < 1024; ++k) g1 += att::bf2f(XN[row * 1024 + k]) * A.w_in[(size_t)k * 8352 + 6304 + n];
        ref = pg8::sigm_f(g1); got = att::bf2f(GMD[row * 2048 + n]); bit = 1u; }
    if (MODE == 7) { const int n = (idx * 40503u + 17u) % 1024u; float y1 = 0.f, y2 = 0.f; const bf16_t* GMD = (const bf16_t*)(dob);
        for (int k = 0; k < 512; ++k) { y1 += att::bf2f(ZM[row * 512 + k]) * A.w_pm[(size_t)k * 1024 + n]; y2 += att::bf2f(ZD[row * 512 + k]) * A.w_pd[(size_t)k * 1024 + n]; }
        ref = att::bf2f(GMD[row * 2048 + n]) * y1 + att::bf2f(GMD[row * 2048 + 1024 + n]) * y2; got = att::bf2f(MRG[row * 1024 + n]); bit = 2u; }
    if (MODE == 8) { const int n = (idx * 40503u + 17u) % 2048u, k = ((hsh >> 3) * 7919u + 3u) % 1021u; const bf16_t* Win_t = (const bf16_t*)(ws + WS_WIN);
        ref = A.w_in[(size_t)k * 8352 + 6304 + n]; got = att::bf2f(Win_t[(size_t)(6400 + n) * 1024 + k]); bit = 2u; }
    if (MODE == 9) { const int n = (idx * 40503u + 17u) % 5632u, k = ((hsh >> 3) * 7919u + 3u) % 1021u; const bf16_t* Win_t = (const bf16_t*)(ws + WS_WIN);
        ref = A.w_in[(size_t)k * 8352 + 672 + n]; got = att::bf2f(Win_t[(size_t)n * 1024 + k]); bit = 8u; }
    if (MODE == 5) { const int i = idx % 24u; const float p = (float)A.pos[row];
        if (i < 16) { const float inv = powf(500000.0f, -(float)(2 * i) / 32.0f); const float a = p * inv; ref = (idx & 32u) ? cosf(a) : sinf(a); got = (idx & 32u) ? cosm[row * 16 + i] : sinm[row * 16 + i]; }
        else { const int k = i - 16; const float inv = powf(500000.0f, -(float)(2 * k) / 16.0f); const float a = p * inv; ref = (idx & 32u) ? cosf(a) : sinf(a); got = (idx & 32u) ? cosd[row * 8 + k] : sind[row * 8 + k]; }
        bit = 16u; }
    const float err = fabsf(got - ref), tol = (MODE == 5) ? 2e-3f : (MODE == 8 || MODE == 9) ? 2e-4f + 0.01f * fabsf(ref) : 0.04f + 0.03f * fabsf(ref);
    if (!(err <= tol)) { atomicOr(flags, bit); if (MODE == 6) { const unsigned nn = ((idx * 40503u + 17u) % 2048u) & 255u, rr = (unsigned)row & 255u; atomicMax(flags + 1, nn + 1u); atomicMax(flags + 2, 256u - nn); atomicMax(flags + 3, rr + 1u); atomicMax(flags + 4, 256u - rr); } }
}
#endif

#if DEBUG_NAIVE_GEMM
template <int MODE> __global__ void __launch_bounds__(256) naive_gemm(Args A_, const bf16_t* Am, int K, const float* W, int ldw, int woff, int N) {
    __shared__ float As[16][65]; __shared__ float Bs[16][65];
    unsigned char* ws = A_.ws; unsigned char* dob = (unsigned char*)A_.out;
    bf16_t* QKVD = (bf16_t*)(ws + WS_QKVD); bf16_t* ZM = (bf16_t*)(ws + WS_ZM); bf16_t* ZD = (bf16_t*)(ws + WS_ZD);
    bf16_t* GMD = (bf16_t*)(dob); bf16_t* MRG = (bf16_t*)(ws + WS_MRG); bf16_t* Y = (bf16_t*)(ws + WS_Y);
    bf16_t* CL = (bf16_t*)(dob + DO_CL); bf16_t* Vb = (bf16_t*)(dob + DO_V); bf16_t* Qb = (bf16_t*)(dob + DO_Q); bf16_t* KN = (bf16_t*)(dob + DO_KN);
    const int tid = threadIdx.x, tx = tid & 15, ty = tid >> 4;
    const int m0 = blockIdx.y * 64, n0 = blockIdx.x * 64;
    float acc[4][4];
#pragma unroll
    for (int i = 0; i < 4; ++i)
#pragma unroll
        for (int j = 0; j < 4; ++j) acc[i][j] = 0.f;
    for (int k0 = 0; k0 < K; k0 += 16) {
#pragma unroll
        for (int e = 0; e < 4; ++e) { const int idx = tid + 256 * e; const int r = idx >> 4, kk = idx & 15; As[kk][r] = att::bf2f(Am[(size_t)(m0 + r) * K + k0 + kk]); }
#pragma unroll
        for (int e = 0; e < 4; ++e) { const int idx = tid + 256 * e; const int kk = idx >> 6, c = idx & 63; const int n = n0 + c; Bs[kk][c] = n < N ? W[(size_t)(k0 + kk) * ldw + woff + n] : 0.f; }
        __syncthreads();
#pragma unroll
        for (int kk = 0; kk < 16; ++kk) { float a[4], b[4];
#pragma unroll
            for (int i = 0; i < 4; ++i) { a[i] = As[kk][ty * 4 + i]; b[i] = Bs[kk][tx * 4 + i]; }
#pragma unroll
            for (int i = 0; i < 4; ++i)
#pragma unroll
                for (int j = 0; j < 4; ++j) acc[i][j] += a[i] * b[j]; }
        __syncthreads();
    }
#pragma unroll
    for (int i = 0; i < 4; ++i)
#pragma unroll
        for (int j = 0; j < 4; ++j) {
            const size_t row = m0 + ty * 4 + i; const int n = n0 + tx * 4 + j; if (n >= N) continue; const float v = acc[i][j];
            if (MODE == 0) { if (n < 672) CL[row * 768 + n] = att::f2bf(v); else if (n < 5280) QKVD[row * 4608 + n - 672] = att::f2bf(v);
                else if (n < 5792) ZM[row * 512 + n - 5280] = att::f2bf(pg8::silu_f(v)); else ZD[row * 512 + n - 5792] = att::f2bf(pg8::silu_f(v)); }
            if (MODE == 1) Qb[row * 768 + n] = att::f2bf(v);
            if (MODE == 2) { const int hh = n >> 7, w = n & 127; if (w < 64) KN[row * 512 + hh * 64 + w] = att::f2bf(v); else Vb[row * 512 + hh * 64 + w - 64] = att::f2bf(v); }
            if (MODE == 3) GMD[row * 2048 + n] = att::f2bf(pg8::sigm_f(v));
            if (MODE == 4) MRG[row * 1024 + n] = att::f2bf(v * att::bf2f(GMD[row * 2048 + n]));
            if (MODE == 5) MRG[row * 1024 + n] = att::f2bf(att::bf2f(MRG[row * 1024 + n]) + v * att::bf2f(GMD[row * 2048 + 1024 + n]));
            if (MODE == 6) Y[row * 1024 + n] = att::f2bf(v);
        }
}
#endif

extern "C" void kernel_launch(void* const* d_in, const int* in_sizes, int n_in, void* d_out, int out_size, void* d_ws, size_t ws_size, hipStream_t stream) {
    static int grid = 0;
    if (grid == 0) {
        if (n_in != 12 || out_size != T * DM || ws_size < WS_END) { fprintf(stderr, "kernel_launch: unexpected problem shape / workspace (%d inputs, out %d, ws %zu)\n", n_in, out_size, ws_size); grid = -1; return; }
        int dev = 0, cus = 0, per_cu = 0;
        (void)hipGetDevice(&dev); (void)hipDeviceGetAttribute(&cus, hipDeviceAttributeMultiprocessorCount, dev);
        (void)hipFuncSetAttribute((const void*)fwd_kernel, hipFuncAttributeMaxDynamicSharedMemorySize, LDS_BYTES);
        (void)hipOccupancyMaxActiveBlocksPerMultiprocessor(&per_cu, (const void*)fwd_kernel, 512, LDS_BYTES);
        (void)hipGetLastError();
        if (per_cu < 1) per_cu = 1;
        grid = cus * 1;
    }
    if (grid < 0) return;
    (void)hipMemsetAsync(d_ws, 0, 65536 + 2 * 131072, stream);
#if DEBUG_CHECK
    (void)hipMemsetAsync(d_ws, 0, 256, stream);
#endif
    Args a{};
    a.x = (const float*)d_in[0]; a.pos = (const int*)d_in[1]; a.pre_g = (const float*)d_in[2]; a.w_in = (const float*)d_in[3]; a.q_g = (const float*)d_in[4]; a.w_uq = (const float*)d_in[5];
    a.kv_g = (const float*)d_in[6]; a.w_ukv = (const float*)d_in[7]; a.w_pm = (const float*)d_in[8]; a.w_pd = (const float*)d_in[9]; a.w_out = (const float*)d_in[10]; a.post_g = (const float*)d_in[11];
    a.out = (float*)d_out; a.ws = (unsigned char*)d_ws;
    if (N_LAUNCH_MODE == 1) {
        a.ph_lo = 0; a.ph_hi = 10; void* args[] = {&a};
        hipError_t e = hipLaunchCooperativeKernel((const void*)fwd_kernel, dim3(grid), dim3(512), args, LDS_BYTES, stream);
        if (e != hipSuccess) fprintf(stderr, "cooperative launch failed: %s (grid %d)\n", hipGetErrorString(e), grid);
    } else {
        for (int p = 0; p < 10; ++p) { a.ph_lo = p; a.ph_hi = p + 1;
#if DEBUG_NAIVE_GEMM
            bf16_t* XN_ = (bf16_t*)((unsigned char*)d_ws + WS_XN); bf16_t* CQN_ = (bf16_t*)((unsigned char*)d_ws + WS_CQN); bf16_t* CKVN_ = (bf16_t*)((unsigned char*)d_ws + WS_CKVN);
            bf16_t* ZM_ = (bf16_t*)((unsigned char*)d_ws + WS_ZM); bf16_t* ZD_ = (bf16_t*)((unsigned char*)d_ws + WS_ZD); bf16_t* MRG_ = (bf16_t*)((unsigned char*)d_ws + WS_MRG);
            if (p == 1 && (DEBUG_NAIVE_GEMM & 1)) { hipLaunchKernelGGL(naive_gemm<0>, dim3((6304 + 63) / 64, T / 64), dim3(256), 0, stream, a, XN_, 1024, a.w_in, 8352, 0, 6304); continue; }
            if (p == 3 && (DEBUG_NAIVE_GEMM & 2)) { hipLaunchKernelGGL(naive_gemm<1>, dim3(768 / 64, T / 64), dim3(256), 0, stream, a, CQN_, 384, a.w_uq, 768, 0, 768);
                hipLaunchKernelGGL(naive_gemm<2>, dim3(1024 / 64, T / 64), dim3(256), 0, stream, a, CKVN_, 256, a.w_ukv, 1024, 0, 1024); continue; }
            if (p == 66 && (DEBUG_NAIVE_GEMM & 4)) { hipLaunchKernelGGL(naive_gemm<3>, dim3(2048 / 64, T / 64), dim3(256), 0, stream, a, XN_, 1024, a.w_in, 8352, 6304, 2048);
                hipLaunchKernelGGL(naive_gemm<4>, dim3(1024 / 64, T / 64), dim3(256), 0, stream, a, ZM_, 512, a.w_pm, 1024, 0, 1024);
                hipLaunchKernelGGL(naive_gemm<5>, dim3(1024 / 64, T / 64), dim3(256), 0, stream, a, ZD_, 512, a.w_pd, 1024, 0, 1024); continue; }
            if (p == 77 && (DEBUG_NAIVE_GEMM & 8)) { hipLaunchKernelGGL(naive_gemm<6>, dim3(1024 / 64, T / 64), dim3(256), 0, stream, a, MRG_, 1024, a.w_out, 1024, 0, 1024); continue; }
#endif
            hipLaunchKernelGGL(fwd_kernel, dim3(grid), dim3(512), LDS_BYTES, stream, a);
#if DEBUG_CHECK
            if (p == 0) hipLaunchKernelGGL(check_kernel<5>, dim3(32), dim3(256), 0, stream, a);
            if (p == 7) hipLaunchKernelGGL(check_kernel<6>, dim3(64), dim3(256), 0, stream, a);
            if (p == 0) hipLaunchKernelGGL(check_kernel<8>, dim3(64), dim3(256), 0, stream, a);
            if (p == 5) hipLaunchKernelGGL(check_kernel<8>, dim3(64), dim3(256), 0, stream, a);
            if (p == 5) hipLaunchKernelGGL(check_kernel<9>, dim3(64), dim3(256), 0, stream, a);
            if (p == 7) hipLaunchKernelGGL(check_kernel<3>, dim3(32), dim3(256), 0, stream, a);
#endif
#if DEBUG_NAIVE_MLA
            if (p == 4) hipLaunchKernelGGL(naive_mla, dim3(T * 8 / 256), dim3(256), 0, stream, a);
#endif
#if DEBUG_NAIVE_DIL
            if (p == 4) hipLaunchKernelGGL(naive_dil, dim3(T * 24 / 256), dim3(256), 0, stream, a);
#endif
        }
    }
}
```

```cpp
#define DEBUG_NAIVE_MLA 0
#define DEBUG_NAIVE_DIL 0
#define DEBUG_NAIVE_GEMM 0
#define DEBUG_CHECK 0
#define N_LAUNCH_MODE 1
#include <hip/hip_runtime.h>
#include <hip/hip_cooperative_groups.h>
#include <cstdio>
#include <cstdint>
#include <cmath>
namespace cg = cooperative_groups;
namespace pg8 {
#define PG8_LAS __attribute__((address_space(3)))
typedef unsigned short bf16_t;
typedef short bf16x8 __attribute__((ext_vector_type(8)));
typedef float f32x4 __attribute__((ext_vector_type(4)));
typedef unsigned u32x4 __attribute__((ext_vector_type(4)));
constexpr int BM = 256, BK = 64, HALF = 128, HTB = HALF * BK * 2  , STAGE_BYTES = 8 * HTB, NXCD = 8, WGM = 8;

__host__ __device__ __forceinline__ int lds_byte(int r, int c) { const int st = (r >> 4) * 2 + (c >> 5), rr = r & 15, cc = c & 31, ob = rr * 64 + cc * 2; return st * 1024 + (ob ^ (((ob >> 9) & 1) << 5)); }
__host__ __device__ __forceinline__ void stage_rc(int b, int& R, int& C) { const int st = b / 1024, sb = b % 1024, swz = sb ^ (((sb >> 9) & 1) << 5); R = (st >> 1) * 16 + swz / 64; C = (st & 1) * 32 + (swz % 64) / 2; }
__host__ __device__ __forceinline__ int perm32(int rho) { const int n = rho >> 4, i = rho & 15; return 8 * (i >> 2) + 4 * n + (i & 3); }

struct Unit { int pm, pn; };
struct Gemm { const bf16_t* A; const bf16_t* Bt; int M, N, K; int lda; };

struct StaticOrder {
    int nM, nN, nwg, G, c;
    __host__ __device__ void init(int M, int N, int G_, int c_) { nM = M / BM; nN = N / BM; nwg = nM * nN; G = G_; c = c_; }
    __host__ __device__ bool next(int i, Unit& u) const {
        const long L = (long)i * G + c; if (L >= nwg) return false;
        int wgid = (int)L; { const int q = nwg / NXCD, r = nwg % NXCD, xcd = wgid % NXCD, off = wgid / NXCD; wgid = (xcd < r ? xcd * (q + 1) : r * (q + 1) + (xcd - r) * q) + off; }
        const int nig = WGM * nN, gid = wgid / nig, fm = gid * WGM, gsz = (nM - fm) < WGM ? (nM - fm) : WGM;
        u.pm = fm + ((wgid % nig) % gsz); u.pn = (wgid % nig) / gsz; return true;
    }
    __device__ __forceinline__ void a_ready(const Unit&) const {}
    __device__ __forceinline__ void done(const Unit&) const {}
};

typedef float f32x2c_t __attribute__((ext_vector_type(2))); typedef __bf16 bf16x2c_t __attribute__((ext_vector_type(2)));
__device__ __forceinline__ unsigned cvt_pk_bf16(float lo, float hi) { f32x2c_t v = {lo, hi}; bf16x2c_t b = __builtin_convertvector(v, bf16x2c_t); return __builtin_bit_cast(unsigned, b); }
typedef float f32x2 __attribute__((ext_vector_type(2)));
typedef unsigned u32x4v __attribute__((ext_vector_type(4)));
typedef unsigned u32x2v __attribute__((ext_vector_type(2)));
__device__ __forceinline__ float bf_lo(unsigned w) { return __uint_as_float(w << 16); }
__device__ __forceinline__ float bf_hi(unsigned w) { return __uint_as_float(w & 0xffff0000u); }
__device__ __forceinline__ float sigm_f(float v) { return __builtin_amdgcn_rcpf(1.f + __builtin_amdgcn_exp2f(-1.4426950408889634f * v)); }
__device__ __forceinline__ float silu_f(float v) { return v * sigm_f(v); }
__device__ __forceinline__ u32x4v pack8(const f32x4& v0, const f32x4& v1) { u32x4v w; w.x = cvt_pk_bf16(v0[0], v0[1]); w.y = cvt_pk_bf16(v0[2], v0[3]); w.z = cvt_pk_bf16(v1[0], v1[1]); w.w = cvt_pk_bf16(v1[2], v1[3]); return w; }
#define EPI_LOOP_BEGIN(base_, ldc_, colt_) { const int row0_ = u.pm * BM + wr * 64 + fr; const int col0_ = (colt_) + wc * 32 + 8 * fq; \
    _Pragma("unroll") for (int ai = 0; ai < 2; ++ai) _Pragma("unroll") for (int m = 0; m < 4; ++m) { const size_t roff_ = (size_t)(row0_ + ai * HALF + m * 16); \
    _Pragma("unroll") for (int bj = 0; bj < 2; ++bj) { f32x4 v0 = acc[ai][bj][m][0], v1 = acc[ai][bj][m][1]; const int cc_ = col0_ + bj * HALF; bf16_t* optr = (base_) + roff_ * (ldc_) + cc_;
#define EPI_LOOP_END } } }
struct EpiIn {
    static constexpr bool PERM = true, AFTER_DRAIN = false;
    bf16_t *QKVD, *ZM, *ZD, *CL; float *ssq_q, *ssq_kv;
    __device__ __forceinline__ void operator()(const f32x4 (&acc)[2][2][4][2], const Unit& u, int wr, int wc, int fr, int fq) const {
        const int pn = u.pn; bf16_t* base; int ldc, colt; bool act = false;
        if (pn < 18) { base = QKVD; ldc = 4608; colt = pn * 256; }
        else if (pn < 20) { base = ZM; ldc = 512; colt = (pn - 18) * 256; act = true; }
        else if (pn < 22) { base = ZD; ldc = 512; colt = (pn - 20) * 256; act = true; }
        else { base = CL; ldc = 768; colt = (pn - 22) * 256;
            const int row0s = u.pm * BM + wr * 64 + fr;
#pragma unroll
            for (int ai = 0; ai < 2; ++ai)
#pragma unroll
                for (int m = 0; m < 4; ++m)
#pragma unroll
                    for (int bj = 0; bj < 2; ++bj) { const f32x4 a0 = acc[ai][bj][m][0], a1 = acc[ai][bj][m][1];
                        float sacc = (a0[0] * a0[0] + a0[1] * a0[1]) + (a0[2] * a0[2] + a0[3] * a0[3]) + (a1[0] * a1[0] + a1[1] * a1[1]) + (a1[2] * a1[2] + a1[3] * a1[3]);
                        sacc += __shfl_xor(sacc, 16); sacc += __shfl_xor(sacc, 32);
                        const int seg = (pn - 22) * 2 + bj;
                        if (fq == 0 && seg < 5) atomicAdd((seg < 3 ? ssq_q : ssq_kv) + row0s + ai * HALF + m * 16, sacc); } }
        EPI_LOOP_BEGIN(base, ldc, colt)
            if (act) { _Pragma("unroll") for (int e = 0; e < 4; ++e) { v0[e] = silu_f(v0[e]); v1[e] = silu_f(v1[e]); } }
            *(u32x4v*)optr = pack8(v0, v1);
        EPI_LOOP_END
    }
};
struct EpiSig {
    static constexpr bool PERM = true, AFTER_DRAIN = false;
    bf16_t* O; int ldc;
    __device__ __forceinline__ void operator()(const f32x4 (&acc)[2][2][4][2], const Unit& u, int wr, int wc, int fr, int fq) const {
        EPI_LOOP_BEGIN(O, ldc, u.pn * 256)
            _Pragma("unroll") for (int e = 0; e < 4; ++e) { v0[e] = sigm_f(v0[e]) * 255.0f + 0.5f; v1[e] = sigm_f(v1[e]) * 255.0f + 0.5f; }
            unsigned char* bp = (unsigned char*)O + roff_ * (size_t)ldc + cc_;
            u32x2v w; w.x = (unsigned)v0[0] | ((unsigned)v0[1] << 8) | ((unsigned)v0[2] << 16) | ((unsigned)v0[3] << 24); w.y = (unsigned)v1[0] | ((unsigned)v1[1] << 8) | ((unsigned)v1[2] << 16) | ((unsigned)v1[3] << 24);
            *(u32x2v*)bp = w; (void)optr;
        EPI_LOOP_END
    }
};
struct EpiStore {
    static constexpr bool PERM = true, AFTER_DRAIN = false;
    bf16_t* O0; int ld0; int split; bf16_t* O1; int ld1;
    __device__ __forceinline__ void operator()(const f32x4 (&acc)[2][2][4][2], const Unit& u, int wr, int wc, int fr, int fq) const {
        const bool first = u.pn < split; bf16_t* base = first ? O0 : O1; const int ldc = first ? ld0 : ld1; const int colt = (first ? u.pn : u.pn - split) * 256;
        EPI_LOOP_BEGIN(base, ldc, colt)
            *(u32x4v*)optr = pack8(v0, v1);
        EPI_LOOP_END
    }
};
struct EpiScaleStore {
    static constexpr bool PERM = true, AFTER_DRAIN = false;
    bf16_t* O0; int ld0; int split; bf16_t* O1; int ld1; const float* ssq; float invn;
    __device__ __forceinline__ void operator()(const f32x4 (&acc)[2][2][4][2], const Unit& u, int wr, int wc, int fr, int fq) const {
        const bool first = u.pn < split; bf16_t* base = first ? O0 : O1; const int ldc = first ? ld0 : ld1; const int colt = (first ? u.pn : u.pn - split) * 256;
        float rs[2][4];
#pragma unroll
        for (int ai = 0; ai < 2; ++ai)
#pragma unroll
            for (int m = 0; m < 4; ++m) rs[ai][m] = 1.0f / sqrtf(ssq[u.pm * BM + wr * 64 + fr + ai * HALF + m * 16] * invn + 1e-6f);
        EPI_LOOP_BEGIN(base, ldc, colt)
            v0 = v0 * rs[ai][m]; v1 = v1 * rs[ai][m];
            *(u32x4v*)optr = pack8(v0, v1);
        EPI_LOOP_END
    }
};
template <bool ADD> struct EpiGate {
    static constexpr bool PERM = true, AFTER_DRAIN = false;
    bf16_t* O; int ldc; const bf16_t* G; int ldg; int goff;
    __device__ __forceinline__ void operator()(const f32x4 (&acc)[2][2][4][2], const Unit& u, int wr, int wc, int fr, int fq) const {
        EPI_LOOP_BEGIN(O, ldc, u.pn * 256)
            const u32x2v g = *(const u32x2v*)((const unsigned char*)G + roff_ * (size_t)ldg + goff + cc_);
            constexpr float k_ = 1.0f / 255.0f;
            v0[0] *= (float)(g.x & 255u) * k_; v0[1] *= (float)((g.x >> 8) & 255u) * k_; v0[2] *= (float)((g.x >> 16) & 255u) * k_; v0[3] *= (float)(g.x >> 24) * k_;
            v1[0] *= (float)(g.y & 255u) * k_; v1[1] *= (float)((g.y >> 8) & 255u) * k_; v1[2] *= (float)((g.y >> 16) & 255u) * k_; v1[3] *= (float)(g.y >> 24) * k_;
            if (ADD) { const u32x4v p = *(const u32x4v*)optr;
                v0[0] += bf_lo(p.x); v0[1] += bf_hi(p.x); v0[2] += bf_lo(p.y); v0[3] += bf_hi(p.y); v1[0] += bf_lo(p.z); v1[1] += bf_hi(p.z); v1[2] += bf_lo(p.w); v1[3] += bf_hi(p.w); }
            *(u32x4v*)optr = pack8(v0, v1);
        EPI_LOOP_END
    }
};
struct GateOrder {
    StaticOrder S;
    __host__ __device__ bool next(int i, Unit& u) const { if (!S.next(i >> 1, u)) return false; u.pn += 4 * (i & 1); return true; }
    __device__ __forceinline__ void a_ready(const Unit&) const {}
    __device__ __forceinline__ void done(const Unit&) const {}
};
template <class Epi, class Sched, bool ALIGN_EPI = false, bool SP2 = false>
__device__ __forceinline__ void gemm_phase(PG8_LAS unsigned char* lds, const Gemm g, const Sched& S, const Epi& E) {
    const int tid = threadIdx.x, wid = __builtin_amdgcn_readfirstlane(tid >> 6), lane = tid & 63, wr = wid >> 2, wc = wid & 3, fr = lane & 15, fq = lane >> 4;
    const int K = g.K, nt = K / BK;
    const int lda = g.lda ? g.lda : K;
    unsigned voffA[2], voffB[2];
#pragma unroll
    for (int i = 0; i < 2; ++i) { int R, C; stage_rc(tid * 16 + i * 8192, R, C); const int Rb = Epi::PERM ? ((R & ~31) + perm32(R & 31)) : R;
        voffA[i] = (unsigned)(R * lda + C) * 2u; voffB[i] = (unsigned)(Rb * K + C) * 2u; }
    const size_t kstep = (size_t)(BK * 2);
    const size_t hstep = (size_t)HALF * K * 2;
    const size_t tstep = 2 * hstep;
    const size_t hstepA = (size_t)HALF * lda * 2, tstepA = 2 * hstepA;
    const unsigned ldsw = (unsigned)wid * 1024u;
    const int aoff = lds_byte(wr * 64 + fr, fq * 8), boff = lds_byte(wc * 32 + fr, fq * 8);
#define PG8_SA(b, h) (((b) * 2 + (h)) * HTB)
#define PG8_SB(b, h) ((4 + (b) * 2 + (h)) * HTB)
#define PG8_STAGE(bufoff, gbase, voff) do { _Pragma("unroll") for (int _i = 0; _i < 2; ++_i) \
        __builtin_amdgcn_global_load_lds((const unsigned*)((const char*)(gbase) + (voff)[_i]), (PG8_LAS unsigned*)(lds + (bufoff) + ldsw + _i * 8192), 16, 0, 0); } while (0)
#define PG8_LDA(dst, b, h) do { _Pragma("unroll") for (int m = 0; m < 4; ++m) _Pragma("unroll") for (int k = 0; k < 2; ++k) dst[m][k] = *(const PG8_LAS bf16x8*)(lds + PG8_SA(b, h) + aoff + m * 2048 + k * 1024); } while (0)
#define PG8_LDB(dst, b, h) do { _Pragma("unroll") for (int n = 0; n < 2; ++n) _Pragma("unroll") for (int k = 0; k < 2; ++k) dst[n][k] = *(const PG8_LAS bf16x8*)(lds + PG8_SB(b, h) + boff + n * 2048 + k * 1024); } while (0)
#define PG8_MMA(ai, bj, At, Bt) do { __builtin_amdgcn_s_setprio(1); _Pragma("unroll") for (int m = 0; m < 4; ++m) _Pragma("unroll") for (int n = 0; n < 2; ++n) _Pragma("unroll") for (int k = 0; k < 2; ++k) \
        acc[ai][bj][m][n] = __builtin_amdgcn_mfma_f32_16x16x32_bf16(Bt[n][k], At[m][k], acc[ai][bj][m][n], 0, 0, 0); __builtin_amdgcn_s_setprio(0); } while (0)
#define PG8_WAIT_V(n) asm volatile("s_waitcnt vmcnt(" #n ")" ::: "memory")
#define PG8_WAIT_L(n) asm volatile("s_waitcnt lgkmcnt(" #n ")" ::: "memory")
#define PG8_BAR __builtin_amdgcn_s_barrier()
#define PG8_SCHED __builtin_amdgcn_sched_barrier(0)
    Unit cur, nxt; int ui = 0;
    if (!S.next(0, cur)) return;
    f32x4 acc[2][2][4][2];
#pragma unroll
    for (int a = 0; a < 2; ++a)
#pragma unroll
        for (int b = 0; b < 2; ++b)
#pragma unroll
            for (int m = 0; m < 4; ++m)
#pragma unroll
                for (int n = 0; n < 2; ++n) acc[a][b][m][n] = (f32x4){0.f, 0.f, 0.f, 0.f};
    bf16x8 At[4][2], B0[2][2], B1[2][2];
    const char* cA = (const char*)g.A + (size_t)cur.pm * tstepA; const char* cB = (const char*)g.Bt + (size_t)cur.pn * tstep;
    S.a_ready(cur);
    if constexpr (SP2) {
        PG8_STAGE(PG8_SB(0, 0), cB, voffB); PG8_STAGE(PG8_SB(0, 1), cB + hstep, voffB); PG8_STAGE(PG8_SA(0, 0), cA, voffA); PG8_STAGE(PG8_SA(0, 1), cA + hstepA, voffA);
        if (wr == 1) PG8_BAR;
        PG8_WAIT_V(2); PG8_BAR;
        PG8_STAGE(PG8_SB(1, 0), cB + kstep, voffB); PG8_STAGE(PG8_SA(1, 0), cA + kstep, voffA); PG8_STAGE(PG8_SB(1, 1), cB + hstep + kstep, voffB);
        PG8_WAIT_V(6); PG8_BAR;
    } else {
        PG8_STAGE(PG8_SB(0, 0), cB, voffB); PG8_STAGE(PG8_SA(0, 0), cA, voffA); PG8_STAGE(PG8_SB(0, 1), cB + hstep, voffB); PG8_STAGE(PG8_SA(0, 1), cA + hstepA, voffA);
        if (wr == 1) PG8_BAR;
        PG8_WAIT_V(4); PG8_BAR;
        PG8_STAGE(PG8_SB(1, 0), cB + kstep, voffB); PG8_STAGE(PG8_SA(1, 0), cA + kstep, voffA); PG8_STAGE(PG8_SB(1, 1), cB + hstep + kstep, voffB);
        PG8_WAIT_V(6); PG8_BAR;
    }
    for (;;) {
        const bool has_next = S.next(ui + 1, nxt);
        const char* nA = has_next ? (const char*)g.A + (size_t)nxt.pm * tstepA : cA; const char* nB = has_next ? (const char*)g.Bt + (size_t)nxt.pn * tstep : cB;
        for (int t = 0; t < nt; t += 2) {
            const bool last = (t == nt - 2);
            const char* a1 = cA + (size_t)(t + 1) * kstep;
            const char* a2 = last ? nA : cA + (size_t)(t + 2) * kstep; const char* b2 = last ? nB : cB + (size_t)(t + 2) * kstep;
            const char* a3 = a2 + kstep; const char* b3 = b2 + kstep;
            if (last && has_next) S.a_ready(nxt);
            if constexpr (SP2) {
            PG8_LDB(B0, 0, 0); PG8_LDB(B1, 0, 1); PG8_SCHED; PG8_LDA(At, 0, 0); PG8_STAGE(PG8_SA(1, 1), a1 + hstepA, voffA);
            PG8_WAIT_V(8); PG8_WAIT_L(0); PG8_BAR; PG8_MMA(0, 0, At, B0); PG8_MMA(0, 1, At, B1); PG8_BAR; PG8_SCHED;
            PG8_LDA(At, 0, 1); PG8_STAGE(PG8_SB(0, 0), b2, voffB); PG8_STAGE(PG8_SB(0, 1), b2 + hstep, voffB); PG8_STAGE(PG8_SA(0, 0), a2, voffA);
            PG8_WAIT_V(8); PG8_WAIT_L(0); PG8_BAR; PG8_MMA(1, 0, At, B0); PG8_MMA(1, 1, At, B1); PG8_BAR; PG8_SCHED;
            PG8_LDB(B0, 1, 0); PG8_LDB(B1, 1, 1); PG8_SCHED; PG8_LDA(At, 1, 0); PG8_STAGE(PG8_SA(0, 1), a2 + hstepA, voffA);
            PG8_WAIT_V(8); PG8_WAIT_L(0); PG8_BAR; PG8_MMA(0, 0, At, B0); PG8_MMA(0, 1, At, B1); PG8_BAR; PG8_SCHED;
            PG8_LDA(At, 1, 1); PG8_STAGE(PG8_SB(1, 0), b3, voffB); PG8_STAGE(PG8_SB(1, 1), b3 + hstep, voffB); PG8_STAGE(PG8_SA(1, 0), a3, voffA);
            PG8_WAIT_V(8); PG8_WAIT_L(0); PG8_BAR; PG8_MMA(1, 0, At, B0); PG8_MMA(1, 1, At, B1); PG8_BAR; PG8_SCHED;
            } else {
            PG8_LDB(B0, 0, 0); PG8_SCHED; PG8_LDA(At, 0, 0); PG8_STAGE(PG8_SA(1, 1), a1 + hstepA, voffA);
            PG8_WAIT_L(8); PG8_BAR; PG8_WAIT_L(0); PG8_MMA(0, 0, At, B0); PG8_BAR; PG8_SCHED;
            PG8_LDB(B1, 0, 1); PG8_STAGE(PG8_SB(0, 0), b2, voffB);
            PG8_BAR; PG8_WAIT_L(0); PG8_MMA(0, 1, At, B1); PG8_BAR;
            PG8_LDA(At, 0, 1); PG8_STAGE(PG8_SA(0, 0), a2, voffA);
            PG8_BAR; PG8_WAIT_L(0); PG8_MMA(1, 0, At, B0); PG8_BAR; PG8_SCHED;
            PG8_STAGE(PG8_SB(0, 1), b2 + hstep, voffB);
            PG8_WAIT_V(6); PG8_BAR; PG8_MMA(1, 1, At, B1); PG8_BAR;
            PG8_LDB(B0, 1, 0); PG8_SCHED; PG8_LDA(At, 1, 0); PG8_STAGE(PG8_SA(0, 1), a2 + hstepA, voffA);
            PG8_WAIT_L(8); PG8_BAR; PG8_WAIT_L(0); PG8_MMA(0, 0, At, B0); PG8_BAR; PG8_SCHED;
            PG8_LDB(B1, 1, 1); PG8_STAGE(PG8_SB(1, 0), b3, voffB);
            PG8_BAR; PG8_WAIT_L(0); PG8_MMA(0, 1, At, B1); PG8_BAR;
            PG8_LDA(At, 1, 1); PG8_STAGE(PG8_SA(1, 0), a3, voffA);
            PG8_BAR; PG8_WAIT_L(0); PG8_MMA(1, 0, At, B0); PG8_BAR; PG8_SCHED;
            PG8_STAGE(PG8_SB(1, 1), b3 + hstep, voffB);
            PG8_WAIT_V(6); PG8_BAR; PG8_MMA(1, 1, At, B1); PG8_BAR;
            }
        }
        if constexpr (ALIGN_EPI) { if (wr == 0) PG8_BAR; }
        if constexpr (!Epi::AFTER_DRAIN) { E(acc, cur, wr, wc, fr, fq); S.done(cur); }
        if (!has_next) break;
#pragma unroll
        for (int a = 0; a < 2; ++a)
#pragma unroll
            for (int b = 0; b < 2; ++b)
#pragma unroll
                for (int m = 0; m < 4; ++m)
#pragma unroll
                    for (int n = 0; n < 2; ++n) acc[a][b][m][n] = (f32x4){0.f, 0.f, 0.f, 0.f};
        cur = nxt; cA = nA; cB = nB; ++ui;
        if constexpr (ALIGN_EPI) { if (wr == 1) PG8_BAR; }
    }
    PG8_WAIT_V(0);
    if constexpr (!ALIGN_EPI) { if (wr == 0) PG8_BAR; }
    PG8_BAR;
    if constexpr (Epi::AFTER_DRAIN) { E.fused(acc, cur, wr, wc, fr, fq, lds, wid, lane); S.done(cur); }
#undef PG8_SA
#undef PG8_SB
#undef PG8_STAGE
#undef PG8_LDA
#undef PG8_LDB
#undef PG8_MMA
#undef PG8_WAIT_V
#undef PG8_WAIT_L
#undef PG8_BAR
#undef PG8_SCHED
}
}

namespace att {
#define LAS __attribute__((address_space(3)))
typedef unsigned short bf16_t;
typedef short bf16x8 __attribute__((ext_vector_type(8)));
typedef short s16x4 __attribute__((ext_vector_type(4)));
typedef float f32x16 __attribute__((ext_vector_type(16)));
typedef unsigned u32x4 __attribute__((ext_vector_type(4)));
typedef unsigned u32x2 __attribute__((ext_vector_type(2)));
typedef float f32x4a __attribute__((ext_vector_type(4)));
constexpr int KBUF = 64 * 208, VSTR = 192, VBUF = 64 * VSTR;
constexpr int KOFF = 0, VOFF = 2 * KBUF, WSF_OFF = VOFF + 2 * VBUF, ATT_LDS = WSF_OFF + 8 * 64 * 4;
__device__ __forceinline__ int crow(int r, int hi) { return (r & 3) + 8 * (r >> 2) + 4 * hi; }
__device__ __forceinline__ unsigned pk_bf16(float lo, float hi) { return pg8::cvt_pk_bf16(lo, hi); }
__device__ __forceinline__ float bf2f(bf16_t b) { return __uint_as_float((unsigned)b << 16); }
__device__ __forceinline__ bf16_t f2bf(float f) { return (bf16_t)(pk_bf16(f, 0.f) & 0xffffu); }
__device__ __forceinline__ float xhalf(float v) { return __shfl_xor(v, 32); }

struct UnitDesc {
    const bf16_t* Q; long q_rs;
    const bf16_t* K; long k_rs;
    const bf16_t* K2; long k2_rs;
    const bf16_t* V; long v_rs;
    const float* cs; const float* sn;
    bf16_t* O; long o_rs;
    float* lse; long lse_rs;
    int q0; int W; float c2;
};

template <bool MLA>
__device__ __forceinline__ void attn_unit(LAS unsigned char* lds, const UnitDesc& d) {
    constexpr int DQK = MLA ? 96 : 64, NKS = DQK / 16, KSTR = DQK * 2 + 16;
    const int tid = threadIdx.x, lane = tid & 63, r32 = lane & 31, hi = lane >> 5;
    const int wid = __builtin_amdgcn_readfirstlane(tid >> 6);
    const int a = d.q0 + wid * 32, qi = a + r32;
    LAS float* wsf = (LAS float*)(lds + WSF_OFF) + wid * 64;
    bf16x8 qr[NKS];
    { const bf16_t* qp = d.Q + (long)qi * d.q_rs + hi * 8;
#pragma unroll
      for (int ks = 0; ks < NKS; ++ks) qr[ks] = *(const bf16x8*)(qp + ks * 16); }
    if constexpr (MLA) {
        const float* cp = d.cs + (long)qi * 16 + hi * 8; const float* sp = d.sn + (long)qi * 16 + hi * 8;
        bf16x8 n1, n2;
#pragma unroll
        for (int e = 0; e < 8; ++e) { const float c = cp[e], s = sp[e], x1 = bf2f((bf16_t)qr[4][e]), x2 = bf2f((bf16_t)qr[5][e]);
            n1[e] = (short)f2bf(x1 * c - x2 * s); n2[e] = (short)f2bf(x2 * c + x1 * s); }
        qr[4] = n1; qr[5] = n2;
    }
    const int j_lo = (d.q0 - d.W > 0 ? d.q0 - d.W : 0) >> 6, j_hi = (d.q0 + 255) >> 6;
    const int wj_lo = (a - d.W > 0 ? a - d.W : 0) >> 6, wj_hi = (a + 31) >> 6;
    const int srow = tid >> 3, sch = tid & 7, s2row = (tid >> 2) & 63, s2ch = tid & 3;
    const bf16_t* kg = d.K + (long)srow * d.k_rs + sch * 8; const bf16_t* vg = d.V + (long)srow * d.v_rs + sch * 8;
    const bf16_t* k2g = MLA ? d.K2 + (long)s2row * d.k2_rs + s2ch * 8 : nullptr;
    const int kst = srow * KSTR + sch * 16, k2st = s2row * KSTR + 128 + s2ch * 16, vst = srow * VSTR + sch * 16;
    u32x4 kreg, vreg, k2reg = {0u, 0u, 0u, 0u};
#define ATT_LOAD(j) do { kreg = *(const u32x4*)(kg + (long)(j) * 64 * d.k_rs); vreg = *(const u32x4*)(vg + (long)(j) * 64 * d.v_rs); \
        if (MLA && tid < 256) k2reg = *(const u32x4*)(k2g + (long)(j) * 64 * d.k2_rs); } while (0)
#define ATT_STORE(buf) do { *(LAS u32x4*)(lds + KOFF + (buf) * KBUF + kst) = kreg; *(LAS u32x4*)(lds + VOFF + (buf) * VBUF + vst) = vreg; \
        if (MLA && tid < 256) *(LAS u32x4*)(lds + KOFF + (buf) * KBUF + k2st) = k2reg; } while (0)
    float m_run = -INFINITY, l_run = 0.f; f32x16 o0 = {}, o1 = {};
    ATT_LOAD(j_lo); ATT_STORE(0); __syncthreads();
    const int kro = r32 * KSTR + hi * 16;
    const int vro = (4 * hi + ((lane & 15) >> 2)) * VSTR + (16 * ((lane >> 4) & 1) + 4 * (lane & 3)) * 2;
    for (int j = j_lo; j <= j_hi; ++j) {
        const int cur = (j - j_lo) & 1;
        if (j < j_hi) ATT_LOAD(j + 1);
        if (j >= wj_lo && j <= wj_hi) {
            const LAS unsigned char* Kb = lds + KOFF + cur * KBUF + kro;
            f32x16 p0 = {}, p1 = {};
#pragma unroll
            for (int ks = 0; ks < NKS; ++ks) {
                const bf16x8 k0 = *(const LAS bf16x8*)(Kb + ks * 32), k1 = *(const LAS bf16x8*)(Kb + 32 * KSTR + ks * 32);
                p0 = __builtin_amdgcn_mfma_f32_32x32x16_bf16(k0, qr[ks], p0, 0, 0, 0);
                p1 = __builtin_amdgcn_mfma_f32_32x32x16_bf16(k1, qr[ks], p1, 0, 0, 0);
            }
            const bool need_mask = (64 * j + 63 > a) || (a + 31 - 64 * j > d.W);
            const int kvb = 64 * j + 4 * hi;
            float mx = -INFINITY;
#pragma unroll
            for (int r = 0; r < 16; ++r) {
                float s0 = p0[r] * d.c2, s1 = p1[r] * d.c2;
                if (need_mask) { const int kv = kvb + (r & 3) + 8 * (r >> 2); const int d0 = qi - kv, d1 = d0 - 32;
                    if (d0 < 0 || d0 > d.W) s0 = -INFINITY; if (d1 < 0 || d1 > d.W) s1 = -INFINITY; }
                p0[r] = s0; p1[r] = s1; mx = fmaxf(mx, fmaxf(s0, s1));
            }
            mx = fmaxf(mx, xhalf(mx));
            const float m_new = fmaxf(m_run, mx);
            const float m_use = (m_new == -INFINITY) ? 0.f : m_new;
            if (__any(m_new > m_run)) {
                const float f = __builtin_amdgcn_exp2f(m_run - m_use);
                l_run *= f;
                if (hi == 0) wsf[r32] = f;
                asm volatile("s_waitcnt lgkmcnt(0)" ::: "memory");
#pragma unroll
                for (int g = 0; g < 4; ++g) { const f32x4a fv = *(const LAS f32x4a*)(wsf + 8 * g + 4 * hi);
                    o0[4 * g + 0] *= fv.x; o0[4 * g + 1] *= fv.y; o0[4 * g + 2] *= fv.z; o0[4 * g + 3] *= fv.w;
                    o1[4 * g + 0] *= fv.x; o1[4 * g + 1] *= fv.y; o1[4 * g + 2] *= fv.z; o1[4 * g + 3] *= fv.w; }
                m_run = m_new;
            }
            float ls = 0.f;
#pragma unroll
            for (int r = 0; r < 16; ++r) { p0[r] = __builtin_amdgcn_exp2f(p0[r] - m_use); p1[r] = __builtin_amdgcn_exp2f(p1[r] - m_use); ls += p0[r] + p1[r]; }
            l_run += ls;
            bf16x8 pa[4];
#pragma unroll
            for (int s = 0; s < 2; ++s) {
                u32x4 w0, w1;
                w0.x = pk_bf16(p0[8 * s + 0], p0[8 * s + 1]); w0.y = pk_bf16(p0[8 * s + 2], p0[8 * s + 3]); w0.z = pk_bf16(p0[8 * s + 4], p0[8 * s + 5]); w0.w = pk_bf16(p0[8 * s + 6], p0[8 * s + 7]);
                w1.x = pk_bf16(p1[8 * s + 0], p1[8 * s + 1]); w1.y = pk_bf16(p1[8 * s + 2], p1[8 * s + 3]); w1.z = pk_bf16(p1[8 * s + 4], p1[8 * s + 5]); w1.w = pk_bf16(p1[8 * s + 6], p1[8 * s + 7]);
                pa[s] = __builtin_bit_cast(bf16x8, w0); pa[2 + s] = __builtin_bit_cast(bf16x8, w1);
            }
            const LAS unsigned char* Vb = lds + VOFF + cur * VBUF + vro;
#pragma unroll
            for (int s = 0; s < 4; ++s) {
#pragma unroll
                for (int d0 = 0; d0 < 2; ++d0) {
                    const LAS unsigned char* vp = Vb + (16 * s) * VSTR + d0 * 64;
                    const s16x4 lo = __builtin_bit_cast(s16x4, __builtin_amdgcn_ds_read_tr16_b64_v4i16((LAS s16x4*)vp));
                    const s16x4 hh = __builtin_bit_cast(s16x4, __builtin_amdgcn_ds_read_tr16_b64_v4i16((LAS s16x4*)(vp + 8 * VSTR)));
                    const bf16x8 vf = (bf16x8){lo[0], lo[1], lo[2], lo[3], hh[0], hh[1], hh[2], hh[3]};
                    if (d0 == 0) o0 = __builtin_amdgcn_mfma_f32_32x32x16_bf16(pa[s], vf, o0, 0, 0, 0);
                    else o1 = __builtin_amdgcn_mfma_f32_32x32x16_bf16(pa[s], vf, o1, 0, 0, 0);
                }
            }
        }
        if (j < j_hi) ATT_STORE(cur ^ 1);
        __syncthreads();
    }
#undef ATT_LOAD
#undef ATT_STORE
    const float l_tot = l_run + xhalf(l_run);
    if (hi == 0) wsf[r32] = __builtin_amdgcn_rcpf(l_tot);
    asm volatile("s_waitcnt lgkmcnt(0)" ::: "memory");
    if constexpr (!MLA) { if (hi == 0) d.lse[(long)qi * d.lse_rs] = (m_run + __builtin_amdgcn_logf(l_tot)) * 0.6931471805599453f; }
#pragma unroll
    for (int r = 0; r < 16; ++r) {
        const int row = crow(r, hi); const float inv = wsf[row];
        bf16_t* op = d.O + (long)(a + row) * d.o_rs + r32;
        if constexpr (MLA) { op[0] = f2bf(o0[r] * inv * bf2f(op[0])); op[32] = f2bf(o1[r] * inv * bf2f(op[32])); }
        else { op[0] = f2bf(o0[r] * inv); op[32] = f2bf(o1[r] * inv); }
    }
    __syncthreads();
}

constexpr int MLA_KBUF = 64 * 208, MLA_VOFF = 3 * MLA_KBUF, MLA_WSF = MLA_VOFF + 3 * VBUF, MLA_LDS = MLA_WSF + 8 * 64 * 4;
__device__ __forceinline__ void mla_pv(const LAS unsigned char* Vb, const bf16x8 (&pa)[4], f32x16& o0, f32x16& o1) {
#pragma unroll
    for (int s = 0; s < 4; ++s) {
#pragma unroll
        for (int d0 = 0; d0 < 2; ++d0) {
            const LAS unsigned char* vp = Vb + (16 * s) * VSTR + d0 * 64;
            const s16x4 lo = __builtin_bit_cast(s16x4, __builtin_amdgcn_ds_read_tr16_b64_v4i16((LAS s16x4*)vp));
            const s16x4 hh = __builtin_bit_cast(s16x4, __builtin_amdgcn_ds_read_tr16_b64_v4i16((LAS s16x4*)(vp + 8 * VSTR)));
            const bf16x8 vf = (bf16x8){lo[0], lo[1], lo[2], lo[3], hh[0], hh[1], hh[2], hh[3]};
            if (d0 == 0) o0 = __builtin_amdgcn_mfma_f32_32x32x16_bf16(pa[s], vf, o0, 0, 0, 0);
            else o1 = __builtin_amdgcn_mfma_f32_32x32x16_bf16(pa[s], vf, o1, 0, 0, 0);
        }
    }
}
__device__ __forceinline__ void mla_unit(LAS unsigned char* lds, const UnitDesc& d) {
    constexpr int NKS = 6, KSTR = 208;
    const int tid = threadIdx.x, lane = tid & 63, r32 = lane & 31, hi = lane >> 5;
    const int wid = __builtin_amdgcn_readfirstlane(tid >> 6);
    const int a = d.q0 + wid * 32, qi = a + r32;
    LAS float* wsf = (LAS float*)(lds + MLA_WSF) + wid * 64;
    bf16x8 qr[NKS];
    { const bf16_t* qp = d.Q + (long)qi * d.q_rs + hi * 8;
#pragma unroll
      for (int ks = 0; ks < NKS; ++ks) qr[ks] = *(const bf16x8*)(qp + ks * 16); }
    {
        const float* cp = d.cs + (long)qi * 16 + hi * 8; const float* sp = d.sn + (long)qi * 16 + hi * 8; const float c2 = d.c2;
        bf16x8 n1, n2;
#pragma unroll
        for (int e = 0; e < 8; ++e) { const float c = cp[e] * c2, s = sp[e] * c2, x1 = bf2f((bf16_t)qr[4][e]), x2 = bf2f((bf16_t)qr[5][e]);
            n1[e] = (short)f2bf(x1 * c - x2 * s); n2[e] = (short)f2bf(x2 * c + x1 * s); }
        qr[4] = n1; qr[5] = n2;
#pragma unroll
        for (int ks = 0; ks < 4; ++ks) { bf16x8 t;
#pragma unroll
            for (int e = 0; e < 8; ++e) t[e] = (short)f2bf(bf2f((bf16_t)qr[ks][e]) * c2);
            qr[ks] = t; }
    }
    const int j_hi = (d.q0 + 255) >> 6, wj_hi = (a + 31) >> 6;
    const int srow = tid >> 3, sch = tid & 7, s2row = (tid >> 2) & 63, s2ch = tid & 3;
    const bf16_t* kg = d.K + (long)srow * d.k_rs + sch * 8; const bf16_t* vg = d.V + (long)srow * d.v_rs + sch * 8;
    const bf16_t* k2g = d.K2 + (long)s2row * d.k2_rs + s2ch * 8;
    const int kst = srow * KSTR + sch * 16, k2st = s2row * KSTR + 128 + s2ch * 16, vst = srow * VSTR + sch * 16;
    u32x4 kreg, vreg, k2reg = {0u, 0u, 0u, 0u};
#define MLA_LOAD(j) do { kreg = *(const u32x4*)(kg + (long)(j) * 64 * d.k_rs); vreg = *(const u32x4*)(vg + (long)(j) * 64 * d.v_rs); \
        if (tid < 256) k2reg = *(const u32x4*)(k2g + (long)(j) * 64 * d.k2_rs); } while (0)
#define MLA_STORE(buf) do { *(LAS u32x4*)(lds + (buf) * MLA_KBUF + kst) = kreg; *(LAS u32x4*)(lds + MLA_VOFF + (buf) * VBUF + vst) = vreg; \
        if (tid < 256) *(LAS u32x4*)(lds + (buf) * MLA_KBUF + k2st) = k2reg; } while (0)
    const int kro = r32 * KSTR + hi * 16;
    const int vro = (4 * hi + ((lane & 15) >> 2)) * VSTR + (16 * ((lane >> 4) & 1) + 4 * (lane & 3)) * 2;
    float m_run = -INFINITY, l_run = 0.f; f32x16 o0 = {}, o1 = {}; f32x16 negm = {};
    f32x16 pA0 = {}, pA1 = {}, pB0 = {}, pB1 = {};
#define MLA_QK(P0, P1, buf) do { const LAS unsigned char* Kb_ = lds + (buf) * MLA_KBUF + kro; \
        _Pragma("unroll") for (int ks = 0; ks < NKS; ++ks) { \
            const bf16x8 k0_ = *(const LAS bf16x8*)(Kb_ + ks * 32), k1_ = *(const LAS bf16x8*)(Kb_ + 32 * KSTR + ks * 32); \
            P0 = __builtin_amdgcn_mfma_f32_32x32x16_bf16(k0_, qr[ks], ks == 0 ? negm : P0, 0, 0, 0); \
            P1 = __builtin_amdgcn_mfma_f32_32x32x16_bf16(k1_, qr[ks], ks == 0 ? negm : P1, 0, 0, 0); } } while (0)
#define MLA_STEP(PC0, PC1, PN0, PN1, j, bc, bn, b2) do { \
        const bool nx_ = (j) + 1 <= wj_hi; \
        if (nx_) MLA_QK(PN0, PN1, bn); \
        if ((j) <= wj_hi) { \
            if (64 * (j) + 63 > a) { const int kvb = 64 * (j) + 4 * hi; \
                _Pragma("unroll") for (int r = 0; r < 16; ++r) { const int kv = kvb + (r & 3) + 8 * (r >> 2); if (kv > qi) PC0[r] = -INFINITY; if (kv + 32 > qi) PC1[r] = -INFINITY; } } \
            float mx = fmaxf(PC0[0], PC1[0]); \
            _Pragma("unroll") for (int r = 1; r < 16; ++r) mx = fmaxf(fmaxf(mx, PC0[r]), PC1[r]); \
              \
            if (__any((m_run == -INFINITY) ? (mx > -INFINITY) : (mx > 8.0f))) { \
                mx = fmaxf(mx, xhalf(mx)); \
                const bool need = (m_run == -INFINITY) ? (mx > -INFINITY) : (mx > 8.0f); \
                const float dl = need ? mx : 0.f; const float f = __builtin_amdgcn_exp2f(-fmaxf(dl, 0.f)); \
                l_run *= f; if (hi == 0) wsf[r32] = f; \
                asm volatile("s_waitcnt lgkmcnt(0)" ::: "memory"); \
                _Pragma("unroll") for (int g = 0; g < 4; ++g) { const f32x4a fv = *(const LAS f32x4a*)(wsf + 8 * g + 4 * hi); \
                    o0[4 * g + 0] *= fv.x; o0[4 * g + 1] *= fv.y; o0[4 * g + 2] *= fv.z; o0[4 * g + 3] *= fv.w; \
                    o1[4 * g + 0] *= fv.x; o1[4 * g + 1] *= fv.y; o1[4 * g + 2] *= fv.z; o1[4 * g + 3] *= fv.w; } \
                _Pragma("unroll") for (int r = 0; r < 16; ++r) { PC0[r] -= dl; PC1[r] -= dl; PN0[r] -= dl; PN1[r] -= dl; } \
                m_run = ((m_run == -INFINITY) ? 0.f : m_run) + dl; \
                _Pragma("unroll") for (int r = 0; r < 16; ++r) negm[r] = -m_run; \
            } \
            float ls = 0.f; \
            _Pragma("unroll") for (int r = 0; r < 16; ++r) { PC0[r] = __builtin_amdgcn_exp2f(PC0[r]); PC1[r] = __builtin_amdgcn_exp2f(PC1[r]); ls += PC0[r] + PC1[r]; } \
            l_run += ls; \
            bf16x8 pa[4]; \
            _Pragma("unroll") for (int s = 0; s < 2; ++s) { u32x4 w0, w1; \
                w0.x = pk_bf16(PC0[8 * s + 0], PC0[8 * s + 1]); w0.y = pk_bf16(PC0[8 * s + 2], PC0[8 * s + 3]); w0.z = pk_bf16(PC0[8 * s + 4], PC0[8 * s + 5]); w0.w = pk_bf16(PC0[8 * s + 6], PC0[8 * s + 7]); \
                w1.x = pk_bf16(PC1[8 * s + 0], PC1[8 * s + 1]); w1.y = pk_bf16(PC1[8 * s + 2], PC1[8 * s + 3]); w1.z = pk_bf16(PC1[8 * s + 4], PC1[8 * s + 5]); w1.w = pk_bf16(PC1[8 * s + 6], PC1[8 * s + 7]); \
                pa[s] = __builtin_bit_cast(bf16x8, w0); pa[2 + s] = __builtin_bit_cast(bf16x8, w1); } \
            mla_pv(lds + MLA_VOFF + (bc) * VBUF + vro, pa, o0, o1); \
        } \
        if ((j) + 2 <= j_hi) MLA_STORE(b2); \
        __syncthreads(); \
        if ((j) + 3 <= j_hi) MLA_LOAD((j) + 3); \
    } while (0)
    MLA_LOAD(0); MLA_STORE(0); MLA_LOAD(1); __syncthreads();
    MLA_QK(pA0, pA1, 0);
    MLA_STORE(1); __syncthreads();
    if (2 <= j_hi) MLA_LOAD(2);
    int bc = 0;
    for (int j = 0; j < j_hi; j += 2) {
        const int bn = (bc == 2) ? 0 : bc + 1, b2 = (bn == 2) ? 0 : bn + 1;
        MLA_STEP(pA0, pA1, pB0, pB1, j, bc, bn, b2);
        MLA_STEP(pB0, pB1, pA0, pA1, j + 1, bn, b2, bc);
        bc = b2;
    }
#undef MLA_LOAD
#undef MLA_STORE
#undef MLA_QK
#undef MLA_STEP
    const float l_tot = l_run + xhalf(l_run);
    if (hi == 0) wsf[r32] = __builtin_amdgcn_rcpf(l_tot);
    asm volatile("s_waitcnt lgkmcnt(0)" ::: "memory");
#pragma unroll
    for (int r = 0; r < 16; ++r) {
        const int row = crow(r, hi); const float inv = wsf[row];
        bf16_t* op = d.O + (long)(a + row) * d.o_rs + r32;
        op[0] = f2bf(o0[r] * inv * bf2f(op[0])); op[32] = f2bf(o1[r] * inv * bf2f(op[32]));
    }
    __syncthreads();
}
constexpr int D2_KB = 64 * 144, D2_VOFF = 4 * D2_KB, D2_WSF = D2_VOFF + 4 * VBUF, D2_LDS = D2_WSF + 8 * 64 * 4;
struct Dil2Desc { const bf16_t* Q; long rs; bf16_t* O; float* lse; long lse_rs; int q0; const float* cs; const float* sn; int dil; };
__device__ __forceinline__ void dil_unit2(LAS unsigned char* lds, const Dil2Desc& d) {
    constexpr int KSTR = 144;
    const int tid = threadIdx.x, lane = tid & 63, r32 = lane & 31, hi = lane >> 5;
    const int wid = __builtin_amdgcn_readfirstlane(tid >> 6);
    const int hg = wid >> 2;
    const int a = d.q0 + (wid & 3) * 32, qi = a + r32;
    LAS float* wsf = (LAS float*)(lds + D2_WSF) + wid * 64;
    constexpr float c2 = 0.125f * 1.4426950408889634f;
    bf16x8 qr[4];
    { const bf16_t* qp = d.Q + (long)qi * d.rs + hg * 64 + hi * 8;
      bf16x8 qv[4];
#pragma unroll
      for (int ks = 0; ks < 4; ++ks) qv[ks] = *(const bf16x8*)(qp + ks * 16);
      const float* cq = d.cs + (long)qi * d.dil * 8; const float* sq = d.sn + (long)qi * d.dil * 8;
      const f32x4a cA = *(const f32x4a*)cq, cB = *(const f32x4a*)(cq + 4), sA = *(const f32x4a*)sq, sB = *(const f32x4a*)(sq + 4);
      {
          const u32x4 own = __builtin_bit_cast(u32x4, qv[0]); u32x4 oth;
          oth.x = (unsigned)__shfl_xor((int)own.x, 32); oth.y = (unsigned)__shfl_xor((int)own.y, 32); oth.z = (unsigned)__shfl_xor((int)own.z, 32); oth.w = (unsigned)__shfl_xor((int)own.w, 32);
          const bf16x8 ov = __builtin_bit_cast(bf16x8, oth); const float sg = hi ? 1.0f : -1.0f; bf16x8 t;
#pragma unroll
          for (int e = 0; e < 8; ++e) { const float c = e < 4 ? cA[e & 3] : cB[e & 3], sn_ = e < 4 ? sA[e & 3] : sB[e & 3];
              t[e] = (short)f2bf((bf2f((bf16_t)qv[0][e]) * c + sg * bf2f((bf16_t)ov[e]) * sn_) * c2); }
          qr[0] = t; }
#pragma unroll
      for (int ks = 1; ks < 4; ++ks) { bf16x8 t;
#pragma unroll
          for (int e = 0; e < 8; ++e) t[e] = (short)f2bf(bf2f((bf16_t)qv[ks][e]) * c2);
          qr[ks] = t; } }
    const int j_lo = (d.q0 - 128 > 0 ? d.q0 - 128 : 0) >> 6, j_hi = (d.q0 + 127) >> 6;
    const int wj_lo = (a - 128 > 0 ? a - 128 : 0) >> 6, wj_hi = (a + 31) >> 6;
    const int srow = tid >> 3, c0 = 2 * (tid & 7), shd = c0 >> 3, sc = c0 & 7;
    const bf16_t* kg = d.Q + 1536 + (long)srow * d.rs + c0 * 8; const bf16_t* vg = d.Q + 3072 + (long)srow * d.rs + c0 * 8;
    const int kst = shd * D2_KB + srow * KSTR + sc * 16, vst = shd * VBUF + srow * VSTR + sc * 16;
    u32x4 kr0, kr1, vr0, vr1; f32x4a kcA = {}, kcB = {}, ksA = {}, ksB = {};
    const bool krope = (sc == 0);
#define D2_LOAD(j) do { const bf16_t* kp_ = kg + (long)(j) * 64 * d.rs; const bf16_t* vp_ = vg + (long)(j) * 64 * d.rs; kr0 = *(const u32x4*)kp_; kr1 = *(const u32x4*)(kp_ + 8); vr0 = *(const u32x4*)vp_; vr1 = *(const u32x4*)(vp_ + 8); \
        if (krope) { const long tr_ = (long)((j) * 64 + srow) * d.dil * 8; kcA = *(const f32x4a*)(d.cs + tr_); kcB = *(const f32x4a*)(d.cs + tr_ + 4); ksA = *(const f32x4a*)(d.sn + tr_); ksB = *(const f32x4a*)(d.sn + tr_ + 4); } } while (0)
#define D2_ROPE2(w1, w2, cl, ch, sl, sh) do { const float a1 = __uint_as_float((w1) << 16), b1 = __uint_as_float((w1) & 0xffff0000u), a2 = __uint_as_float((w2) << 16), b2 = __uint_as_float((w2) & 0xffff0000u); \
        (w1) = pk_bf16(a1 * (cl) - a2 * (sl), b1 * (ch) - b2 * (sh)); (w2) = pk_bf16(a2 * (cl) + a1 * (sl), b2 * (ch) + b1 * (sh)); } while (0)
#define D2_STORE(buf) do { if (krope) { D2_ROPE2(kr0.x, kr1.x, kcA[0], kcA[1], ksA[0], ksA[1]); D2_ROPE2(kr0.y, kr1.y, kcA[2], kcA[3], ksA[2], ksA[3]); \
                                        D2_ROPE2(kr0.z, kr1.z, kcB[0], kcB[1], ksB[0], ksB[1]); D2_ROPE2(kr0.w, kr1.w, kcB[2], kcB[3], ksB[2], ksB[3]); } \
        *(LAS u32x4*)(lds + (buf) * 2 * D2_KB + kst) = kr0; *(LAS u32x4*)(lds + (buf) * 2 * D2_KB + kst + 16) = kr1; \
        *(LAS u32x4*)(lds + D2_VOFF + (buf) * 2 * VBUF + vst) = vr0; *(LAS u32x4*)(lds + D2_VOFF + (buf) * 2 * VBUF + vst + 16) = vr1; } while (0)
    float m_run = -INFINITY, l_run = 0.f; f32x16 o0 = {}, o1 = {};
    D2_LOAD(j_lo); D2_STORE(0); __syncthreads();
    const int kro = hg * D2_KB + r32 * KSTR + hi * 16;
    const int vro = hg * VBUF + (4 * hi + ((lane & 15) >> 2)) * VSTR + (16 * ((lane >> 4) & 1) + 4 * (lane & 3)) * 2;
    for (int j = j_lo; j <= j_hi; ++j) {
        const int cur = (j - j_lo) & 1;
        if (j < j_hi) D2_LOAD(j + 1);
        if (j >= wj_lo && j <= wj_hi) {
            const LAS unsigned char* Kb = lds + cur * 2 * D2_KB + kro;
            f32x16 p0 = {}, p1 = {};
#pragma unroll
            for (int ks = 0; ks < 4; ++ks) {
                const bf16x8 k0 = *(const LAS bf16x8*)(Kb + ks * 32), k1 = *(const LAS bf16x8*)(Kb + 32 * KSTR + ks * 32);
                p0 = __builtin_amdgcn_mfma_f32_32x32x16_bf16(k0, qr[ks], p0, 0, 0, 0);
                p1 = __builtin_amdgcn_mfma_f32_32x32x16_bf16(k1, qr[ks], p1, 0, 0, 0);
            }
            if ((64 * j + 63 > a) || (a + 31 - 64 * j > 128)) {
                const int kvb = 64 * j + 4 * hi;
#pragma unroll
                for (int r = 0; r < 16; ++r) { const int kv = kvb + (r & 3) + 8 * (r >> 2); const int d0 = qi - kv, d1 = d0 - 32;
                    if (d0 < 0 || d0 > 128) p0[r] = -INFINITY; if (d1 < 0 || d1 > 128) p1[r] = -INFINITY; }
            }
            float mx = fmaxf(p0[0], p1[0]);
#pragma unroll
            for (int r = 1; r < 16; ++r) mx = fmaxf(fmaxf(mx, p0[r]), p1[r]);
            if (__any(mx > m_run + 8.0f)) {
                mx = fmaxf(mx, xhalf(mx));
                const bool need = mx > m_run + 8.0f;
                const float m_t = need ? mx : m_run;
                const float f = need ? __builtin_amdgcn_exp2f(m_run - m_t) : 1.0f;
                l_run *= f;
                if (hi == 0) wsf[r32] = f;
                asm volatile("s_waitcnt lgkmcnt(0)" ::: "memory");
#pragma unroll
                for (int g = 0; g < 4; ++g) { const f32x4a fv = *(const LAS f32x4a*)(wsf + 8 * g + 4 * hi);
                    o0[4 * g + 0] *= fv.x; o0[4 * g + 1] *= fv.y; o0[4 * g + 2] *= fv.z; o0[4 * g + 3] *= fv.w;
                    o1[4 * g + 0] *= fv.x; o1[4 * g + 1] *= fv.y; o1[4 * g + 2] *= fv.z; o1[4 * g + 3] *= fv.w; }
                m_run = m_t;
            }
            const float m_use = (m_run == -INFINITY) ? 0.f : m_run;
            float ls = 0.f;
#pragma unroll
            for (int r = 0; r < 16; ++r) { p0[r] = __builtin_amdgcn_exp2f(p0[r] - m_use); p1[r] = __builtin_amdgcn_exp2f(p1[r] - m_use); ls += p0[r] + p1[r]; }
            l_run += ls;
            bf16x8 pa[4];
#pragma unroll
            for (int s = 0; s < 2; ++s) {
                u32x4 w0, w1;
                w0.x = pk_bf16(p0[8 * s + 0], p0[8 * s + 1]); w0.y = pk_bf16(p0[8 * s + 2], p0[8 * s + 3]); w0.z = pk_bf16(p0[8 * s + 4], p0[8 * s + 5]); w0.w = pk_bf16(p0[8 * s + 6], p0[8 * s + 7]);
                w1.x = pk_bf16(p1[8 * s + 0], p1[8 * s + 1]); w1.y = pk_bf16(p1[8 * s + 2], p1[8 * s + 3]); w1.z = pk_bf16(p1[8 * s + 4], p1[8 * s + 5]); w1.w = pk_bf16(p1[8 * s + 6], p1[8 * s + 7]);
                pa[s] = __builtin_bit_cast(bf16x8, w0); pa[2 + s] = __builtin_bit_cast(bf16x8, w1);
            }
            mla_pv(lds + D2_VOFF + cur * 2 * VBUF + vro, pa, o0, o1);
        }
        if (j < j_hi) D2_STORE(cur ^ 1);
        __syncthreads();
    }
#undef D2_LOAD
#undef D2_STORE
#undef D2_ROPE2
    const float l_tot = l_run + xhalf(l_run);
    if (hi == 0) wsf[r32] = __builtin_amdgcn_rcpf(l_tot);
    asm volatile("s_waitcnt lgkmcnt(0)" ::: "memory");
    if (hi == 0) d.lse[(long)qi * d.lse_rs + hg] = (m_run + __builtin_amdgcn_logf(l_tot)) * 0.6931471805599453f;
#pragma unroll
    for (int r = 0; r < 16; ++r) {
        const int row = crow(r, hi); const float inv = wsf[row];
        bf16_t* op = d.O + (long)(a + row) * d.rs + hg * 64 + r32;
        op[0] = f2bf(o0[r] * inv); op[32] = f2bf(o1[r] * inv);
    }
    __syncthreads();
}

__device__ __forceinline__ void dil_unit3(LAS unsigned char* lds, const Dil2Desc& d) {
    constexpr int KSTR = 144;
    const int tid = threadIdx.x, lane = tid & 63, r32 = lane & 31, hi = lane >> 5;
    const int wid = __builtin_amdgcn_readfirstlane(tid >> 6);
    const int a = d.q0 + wid * 32, qi = a + r32;
    LAS float* wsf = (LAS float*)(lds + D2_WSF) + wid * 64;
    constexpr float c2 = 0.125f * 1.4426950408889634f;
    bf16x8 qr[4];
    LAS unsigned char* Qs = lds + D2_LDS + wid * 4096 + lane * 16;
    { const float* cq = d.cs + (long)qi * d.dil * 8; const float* sq = d.sn + (long)qi * d.dil * 8;
      const f32x4a cA = *(const f32x4a*)cq, cB = *(const f32x4a*)(cq + 4), sA = *(const f32x4a*)sq, sB = *(const f32x4a*)(sq + 4);
      const float sg = hi ? 1.0f : -1.0f;
#pragma unroll
      for (int hg = 0; hg < 2; ++hg) {
          const bf16_t* qp = d.Q + (long)qi * d.rs + hg * 64 + hi * 8;
          bf16x8 qv[4];
#pragma unroll
          for (int ks = 0; ks < 4; ++ks) qv[ks] = *(const bf16x8*)(qp + ks * 16);
          const u32x4 own = __builtin_bit_cast(u32x4, qv[0]); u32x4 oth;
          oth.x = (unsigned)__shfl_xor((int)own.x, 32); oth.y = (unsigned)__shfl_xor((int)own.y, 32); oth.z = (unsigned)__shfl_xor((int)own.z, 32); oth.w = (unsigned)__shfl_xor((int)own.w, 32);
          const bf16x8 ov = __builtin_bit_cast(bf16x8, oth); bf16x8 t;
#pragma unroll
          for (int e = 0; e < 8; ++e) { const float c = e < 4 ? cA[e & 3] : cB[e & 3], sn_ = e < 4 ? sA[e & 3] : sB[e & 3];
              t[e] = (short)f2bf((bf2f((bf16_t)qv[0][e]) * c + sg * bf2f((bf16_t)ov[e]) * sn_) * c2); }
          if (hg == 0) qr[0] = t; else *(LAS bf16x8*)(Qs) = t;
#pragma unroll
          for (int ks = 1; ks < 4; ++ks) { bf16x8 t2;
#pragma unroll
              for (int e = 0; e < 8; ++e) t2[e] = (short)f2bf(bf2f((bf16_t)qv[ks][e]) * c2);
              if (hg == 0) qr[ks] = t2; else *(LAS bf16x8*)(Qs + ks * 1024) = t2; } } }
    const int j_lo = (d.q0 - 128 > 0 ? d.q0 - 128 : 0) >> 6, j_hi = (d.q0 + 255) >> 6;
    const int wj_lo = (a - 128 > 0 ? a - 128 : 0) >> 6, wj_hi = (a + 31) >> 6;
    const int srow = tid >> 3, c0 = 2 * (tid & 7), shd = c0 >> 3, sc = c0 & 7;
    const bf16_t* kg = d.Q + 1536 + (long)srow * d.rs + c0 * 8; const bf16_t* vg = d.Q + 3072 + (long)srow * d.rs + c0 * 8;
    const int kst = shd * D2_KB + srow * KSTR + sc * 16, vst = shd * VBUF + srow * VSTR + sc * 16;
    u32x4 kr0, kr1, vr0, vr1; f32x4a kcA = {}, kcB = {}, ksA = {}, ksB = {};
    const bool krope = (sc == 0);
#define D3_LOAD(j) do { const bf16_t* kp_ = kg + (long)(j) * 64 * d.rs; const bf16_t* vp_ = vg + (long)(j) * 64 * d.rs; kr0 = *(const u32x4*)kp_; kr1 = *(const u32x4*)(kp_ + 8); vr0 = *(const u32x4*)vp_; vr1 = *(const u32x4*)(vp_ + 8); \
        if (krope) { const long tr_ = (long)((j) * 64 + srow) * d.dil * 8; kcA = *(const f32x4a*)(d.cs + tr_); kcB = *(const f32x4a*)(d.cs + tr_ + 4); ksA = *(const f32x4a*)(d.sn + tr_); ksB = *(const f32x4a*)(d.sn + tr_ + 4); } } while (0)
#define D3_ROPE2(w1, w2, cl, ch, sl, sh) do { const float a1 = __uint_as_float((w1) << 16), b1 = __uint_as_float((w1) & 0xffff0000u), a2 = __uint_as_float((w2) << 16), b2 = __uint_as_float((w2) & 0xffff0000u); \
        (w1) = pk_bf16(a1 * (cl) - a2 * (sl), b1 * (ch) - b2 * (sh)); (w2) = pk_bf16(a2 * (cl) + a1 * (sl), b2 * (ch) + b1 * (sh)); } while (0)
#define D3_STORE(buf) do { if (krope) { D3_ROPE2(kr0.x, kr1.x, kcA[0], kcA[1], ksA[0], ksA[1]); D3_ROPE2(kr0.y, kr1.y, kcA[2], kcA[3], ksA[2], ksA[3]); \
                                        D3_ROPE2(kr0.z, kr1.z, kcB[0], kcB[1], ksB[0], ksB[1]); D3_ROPE2(kr0.w, kr1.w, kcB[2], kcB[3], ksB[2], ksB[3]); } \
        *(LAS u32x4*)(lds + (buf) * 2 * D2_KB + kst) = kr0; *(LAS u32x4*)(lds + (buf) * 2 * D2_KB + kst + 16) = kr1; \
        *(LAS u32x4*)(lds + D2_VOFF + (buf) * 2 * VBUF + vst) = vr0; *(LAS u32x4*)(lds + D2_VOFF + (buf) * 2 * VBUF + vst + 16) = vr1; } while (0)
    float m_run[2] = {-INFINITY, -INFINITY}, l_run[2] = {0.f, 0.f}; f32x16 o[2][2] = {};
    D3_LOAD(j_lo); D3_STORE(0); __syncthreads();
    const int kro = r32 * KSTR + hi * 16;
    const int vro = (4 * hi + ((lane & 15) >> 2)) * VSTR + (16 * ((lane >> 4) & 1) + 4 * (lane & 3)) * 2;
    for (int j = j_lo; j <= j_hi; ++j) {
        const int cur = (j - j_lo) & 1;
        if (j < j_hi) D3_LOAD(j + 1);
        if (j >= wj_lo && j <= wj_hi) {
            f32x16 pp[2][2] = {};
#pragma unroll
            for (int hg = 0; hg < 2; ++hg) {
                const LAS unsigned char* Kb = lds + cur * 2 * D2_KB + hg * D2_KB + kro;
#pragma unroll
                for (int ks = 0; ks < 4; ++ks) {
                    const bf16x8 k0 = *(const LAS bf16x8*)(Kb + ks * 32), k1 = *(const LAS bf16x8*)(Kb + 32 * KSTR + ks * 32);
                    const bf16x8 qf = hg == 0 ? qr[ks] : *(const LAS bf16x8*)(Qs + ks * 1024);
                    pp[hg][0] = __builtin_amdgcn_mfma_f32_32x32x16_bf16(k0, qf, pp[hg][0], 0, 0, 0);
                    pp[hg][1] = __builtin_amdgcn_mfma_f32_32x32x16_bf16(k1, qf, pp[hg][1], 0, 0, 0);
                } }
#pragma unroll
            for (int hg = 0; hg < 2; ++hg) {
                f32x16& p0 = pp[hg][0]; f32x16& p1 = pp[hg][1]; f32x16& o0 = o[hg][0]; f32x16& o1 = o[hg][1];
                {
                    const int t0 = qi - (64 * j + 4 * hi);
                    if (64 * j + 63 > a) {
#pragma unroll
                        for (int r = 0; r < 16; ++r) { const int off = (r & 3) + 8 * (r >> 2); if (off > t0) p0[r] = -INFINITY; if (off + 32 > t0) p1[r] = -INFINITY; } }
                    if (a + 31 - 64 * j > 128) { const int t1 = t0 - 128;
#pragma unroll
                        for (int r = 0; r < 16; ++r) { const int off = (r & 3) + 8 * (r >> 2); if (off < t1) p0[r] = -INFINITY; if (off + 32 < t1) p1[r] = -INFINITY; } }
                }
                float mx = fmaxf(p0[0], p1[0]);
#pragma unroll
                for (int r = 1; r < 16; ++r) mx = fmaxf(fmaxf(mx, p0[r]), p1[r]);
                if (__any(mx > m_run[hg] + 8.0f)) {
                    mx = fmaxf(mx, xhalf(mx));
                    const bool need = mx > m_run[hg] + 8.0f;
                    const float m_t = need ? mx : m_run[hg];
                    const float f = need ? __builtin_amdgcn_exp2f(m_run[hg] - m_t) : 1.0f;
                    l_run[hg] *= f;
                    if (hi == 0) wsf[r32] = f;
                    asm volatile("s_waitcnt lgkmcnt(0)" ::: "memory");
#pragma unroll
                    for (int g = 0; g < 4; ++g) { const f32x4a fv = *(const LAS f32x4a*)(wsf + 8 * g + 4 * hi);
                        o0[4 * g + 0] *= fv.x; o0[4 * g + 1] *= fv.y; o0[4 * g + 2] *= fv.z; o0[4 * g + 3] *= fv.w;
                        o1[4 * g + 0] *= fv.x; o1[4 * g + 1] *= fv.y; o1[4 * g + 2] *= fv.z; o1[4 * g + 3] *= fv.w; }
                    asm volatile("s_waitcnt lgkmcnt(0)" ::: "memory");
                    m_run[hg] = m_t;
                }
                const float m_use = (m_run[hg] == -INFINITY) ? 0.f : m_run[hg];
                float ls = 0.f;
#pragma unroll
                for (int r = 0; r < 16; ++r) { p0[r] = __builtin_amdgcn_exp2f(p0[r] - m_use); p1[r] = __builtin_amdgcn_exp2f(p1[r] - m_use); ls += p0[r] + p1[r]; }
                l_run[hg] += ls;
                bf16x8 pa[4];
#pragma unroll
                for (int s2 = 0; s2 < 2; ++s2) {
                    u32x4 w0, w1;
                    w0.x = pk_bf16(p0[8 * s2 + 0], p0[8 * s2 + 1]); w0.y = pk_bf16(p0[8 * s2 + 2], p0[8 * s2 + 3]); w0.z = pk_bf16(p0[8 * s2 + 4], p0[8 * s2 + 5]); w0.w = pk_bf16(p0[8 * s2 + 6], p0[8 * s2 + 7]);
                    w1.x = pk_bf16(p1[8 * s2 + 0], p1[8 * s2 + 1]); w1.y = pk_bf16(p1[8 * s2 + 2], p1[8 * s2 + 3]); w1.z = pk_bf16(p1[8 * s2 + 4], p1[8 * s2 + 5]); w1.w = pk_bf16(p1[8 * s2 + 6], p1[8 * s2 + 7]);
                    pa[s2] = __builtin_bit_cast(bf16x8, w0); pa[2 + s2] = __builtin_bit_cast(bf16x8, w1);
                }
                mla_pv(lds + D2_VOFF + cur * 2 * VBUF + hg * VBUF + vro, pa, o0, o1);
            }
        }
        if (j < j_hi) D3_STORE(cur ^ 1);
        __syncthreads();
    }
#undef D3_LOAD
#undef D3_STORE
#undef D3_ROPE2
    LAS unsigned char* stg = lds + wid * 9216;
#pragma unroll
    for (int hg = 0; hg < 2; ++hg) {
        const float l_tot = l_run[hg] + xhalf(l_run[hg]);
        if (hi == 0) wsf[r32] = __builtin_amdgcn_rcpf(l_tot);
        asm volatile("s_waitcnt lgkmcnt(0)" ::: "memory");
        if (hi == 0) d.lse[(long)qi * d.lse_rs + hg] = (m_run[hg] + __builtin_amdgcn_logf(l_tot)) * 0.6931471805599453f;
#pragma unroll
        for (int r = 0; r < 16; ++r) {
            const int row = crow(r, hi); const float inv = wsf[row];
            LAS bf16_t* sp = (LAS bf16_t*)(stg + row * 272) + hg * 64 + r32;
            sp[0] = f2bf(o[hg][0][r] * inv); sp[32] = f2bf(o[hg][1][r] * inv);
        }
        asm volatile("s_waitcnt lgkmcnt(0)" ::: "memory");
    }
#pragma unroll
    for (int it = 0; it < 8; ++it) {
        const int row = it * 4 + (lane >> 4), ch = lane & 15;
        const u32x4 v = *(const LAS u32x4*)(stg + row * 272 + ch * 16);
        *(u32x4*)(d.O + (long)(a + row) * d.rs + ch * 8) = v;
    }
    __syncthreads();
}
#undef LAS
}

#define LAS __attribute__((address_space(3)))
typedef unsigned short bf16_t;
typedef unsigned v4u __attribute__((ext_vector_type(4)));
typedef unsigned v2u __attribute__((ext_vector_type(2)));
typedef float f32x4 __attribute__((ext_vector_type(4)));
constexpr int NB = 8, SEQ = 4096, T = NB * SEQ, DM = 1024;
constexpr int N_IN1 = 6400, N_ALL = 8448;
constexpr float EPS = 1e-6f;
constexpr size_t MiB = 1u << 20;
constexpr size_t WS_WIN = 1 * MiB, WS_WUQ = 18 * MiB, WS_WUKV = 19 * MiB, WS_WPM = 20 * MiB, WS_WPD = 21 * MiB, WS_WOUT = 22 * MiB;
constexpr size_t WS_COSM = 24 * MiB, WS_SINM = 26 * MiB, WS_COSD = 28 * MiB, WS_SIND = 29 * MiB;
constexpr size_t WS_QKVD = 32 * MiB, WS_ZM = 320 * MiB, WS_ZD = 352 * MiB, WS_XN = 384 * MiB;
constexpr size_t WS_CQN = 448 * MiB, WS_CKVN = 472 * MiB, WS_KR = 488 * MiB, WS_LSE = 490 * MiB, WS_END = 512 * MiB;
constexpr size_t WS_GMD = 32 * MiB, WS_MRG = 160 * MiB, WS_Y = 224 * MiB;
constexpr size_t DO_CL = 0, DO_V = 0, DO_Q = 48 * MiB, DO_KN = 96 * MiB;
constexpr int LDS_BYTES = 147456;

struct Args { const float* x; const int* pos; const float* pre_g; const float* w_in; const float* q_g; const float* w_uq; const float* kv_g; const float* w_ukv;
              const float* w_pm; const float* w_pd; const float* w_out; const float* post_g; float* out; unsigned char* ws; int ph_lo, ph_hi; };

__device__ __forceinline__ unsigned f2bf_u(float f) { unsigned u = __builtin_bit_cast(unsigned, f); return (u + 0x7fffu + ((u >> 16) & 1u)) >> 16; }
__device__ __forceinline__ unsigned pk2(float lo, float hi) { return f2bf_u(lo) | (f2bf_u(hi) << 16); }
__device__ __forceinline__ float bflo(unsigned w) { return __uint_as_float(w << 16); }
__device__ __forceinline__ float bfhi(unsigned w) { return __uint_as_float(w & 0xffff0000u); }
__device__ __forceinline__ float wave_sum(float v) {
#pragma unroll
    for (int o = 1; o < 64; o <<= 1) v += __shfl_xor(v, o);
    return v;
}
__device__ __forceinline__ void transpose_item(const float* W, int K, int N, bf16_t* WT, int k0, int sn0, int dn0, LAS float* scr, int lane, const float* gk = nullptr) {
    if (sn0 >= 0) {
#pragma unroll 8
        for (int i = 0; i < 32; ++i) { const int kk = 2 * i + (lane >> 5); scr[kk * 33 + (lane & 31)] = W[(size_t)(k0 + kk) * N + sn0 + (lane & 31)] * (gk ? gk[k0 + kk] : 1.0f); }
    } else {
#pragma unroll 8
        for (int i = 0; i < 32; ++i) { const int kk = 2 * i + (lane >> 5); scr[kk * 33 + (lane & 31)] = 0.f; }
    }
    asm volatile("s_waitcnt lgkmcnt(0)" ::: "memory");
    const int c = lane & 7;
#pragma unroll
    for (int j = 0; j < 4; ++j) { const int n = (lane >> 3) + 8 * j; const LAS float* s = scr + (8 * c) * 33 + n;
        v4u o; o.x = pk2(s[0 * 33], s[1 * 33]); o.y = pk2(s[2 * 33], s[3 * 33]); o.z = pk2(s[4 * 33], s[5 * 33]); o.w = pk2(s[6 * 33], s[7 * 33]);
        *(v4u*)(WT + (size_t)(dn0 + n) * K + k0 + 8 * c) = o; }
    asm volatile("s_waitcnt lgkmcnt(0)" ::: "memory");
}
__device__ __forceinline__ void sincos_rev(float ang, float& c, float& s) {
    const double rev = (double)ang * 0.15915494309189533577; const float fr = (float)(rev - __builtin_rint(rev));
    s = __builtin_amdgcn_sinf(fr); c = __builtin_amdgcn_cosf(fr);
}


#define XB_TMO      128
#define XB_XCNT(j)  (256  + 64 * (j))
#define XB_XSUB(j)  (1280 + 64 * (j))
#define XB_XGEN(j)  (2304 + 64 * (j))
#define XB_TOP      3328
#define XB_TOPGEN   3392
#define XCD_BAR_WORDS 3456
#define XB_SPIN_CAP (1u << 18)

__device__ __forceinline__ unsigned xb_ld(unsigned* p)              { return __hip_atomic_load(p, __ATOMIC_RELAXED, __HIP_MEMORY_SCOPE_AGENT); }
__device__ __forceinline__ unsigned xb_add(unsigned* p, unsigned v) { return __hip_atomic_fetch_add(p, v, __ATOMIC_RELAXED, __HIP_MEMORY_SCOPE_AGENT); }
__device__ __forceinline__ unsigned xb_xcc_id() { return (unsigned)__builtin_amdgcn_s_getreg((3 << 11) | 20) & 0xFu; }
#define XB_SPIN(cond, bar) do { unsigned _sp = 0; while (cond) { __builtin_amdgcn_s_sleep(1); \
    if ((++_sp & 255u) == 0u) { if (xb_ld(&(bar)[XB_TMO])) break; if (_sp > XB_SPIN_CAP) { atomicAdd(&(bar)[XB_TMO], 1u); break; } } } } while (0)

struct XcdBarrier {
    unsigned* bar; unsigned x;
    volatile LAS unsigned* st;
};

__device__ __forceinline__ XcdBarrier xcd_barrier_post(unsigned* bar, volatile LAS unsigned* st) {
    XcdBarrier b; b.bar = bar; b.x = xb_xcc_id(); b.st = st;
    if (threadIdx.x == 0) (void)xb_add(&bar[XB_XCNT(b.x)], 1u);
    return b;
}
__device__ __forceinline__ void xcd_barrier_complete(unsigned* bar, unsigned x, unsigned& nloc, unsigned& nx) {
    const unsigned G = gridDim.x * gridDim.y * gridDim.z;
    unsigned sum, cnt, mine, sp = 0u;
    for (;;) {
        sum = 0u; cnt = 0u; mine = 0u;
#pragma unroll
        for (unsigned j = 0; j < 16; ++j) { const unsigned c = xb_ld(&bar[XB_XCNT(j)]); sum += c; cnt += (c > 0u) ? 1u : 0u; mine = (j == x) ? c : mine; }
        if (sum == G) break;
        __builtin_amdgcn_s_sleep(1);
        if ((++sp & 255u) == 0u) { if (xb_ld(&bar[XB_TMO])) break; if (sp > XB_SPIN_CAP) { atomicAdd(&bar[XB_TMO], 1u); break; } }
    }
    nloc = mine > 0u ? mine : 1u; nx = cnt > 0u ? cnt : 1u;
}

__device__ __forceinline__ void xcd_barrier(const XcdBarrier& b) {
    asm volatile("s_waitcnt vmcnt(0)" ::: "memory");
    __syncthreads();
    if (threadIdx.x == 0) {
        unsigned* bar = b.bar;
        __builtin_amdgcn_s_waitcnt(0);
        unsigned nloc = b.st[0], nx = b.st[1];
        if (nloc == 0u) { xcd_barrier_complete(bar, b.x, nloc, nx); b.st[0] = nloc; b.st[1] = nx; }
        const unsigned old = xb_add(&bar[XB_XSUB(b.x)], 1u);
        const unsigned gen = old / nloc;
        if (old + 1u == (gen + 1u) * nloc) {
            __builtin_amdgcn_fence(__ATOMIC_RELEASE, "agent");
            asm volatile("s_waitcnt vmcnt(0)" ::: "memory");
            const unsigned og = xb_add(&bar[XB_TOP], 1u);
            const unsigned tg = og / nx;
            if (og + 1u == (tg + 1u) * nx) xb_add(&bar[XB_TOPGEN], 1u);
            else XB_SPIN(xb_ld(&bar[XB_TOPGEN]) == tg, bar);
            __builtin_amdgcn_fence(__ATOMIC_ACQUIRE, "agent");
            xb_add(&bar[XB_XGEN(b.x)], 1u);
            asm volatile("s_waitcnt vmcnt(0)" ::: "memory");
        } else {
            XB_SPIN(xb_ld(&bar[XB_XGEN(b.x)]) == gen, bar);
            __builtin_amdgcn_fence(__ATOMIC_ACQUIRE, "agent");
            asm volatile("s_waitcnt vmcnt(0)" ::: "memory");
        }
    }
    __syncthreads();
}

__global__ void __launch_bounds__(512, 2) fwd_kernel(Args A) {
    extern __shared__ __attribute__((aligned(16))) unsigned char lds_raw[];
    LAS unsigned char* lds = (LAS unsigned char*)lds_raw;
#if N_LAUNCH_MODE == 1
    cg::grid_group grid = cg::this_grid();
#endif
    const int tid = threadIdx.x, lane = tid & 63, wave = __builtin_amdgcn_readfirstlane(tid >> 6);
    const int G = gridDim.x, bx = blockIdx.x;
    const int gw = bx * 8 + wave, NGW = G * 8;
    unsigned char* ws = A.ws; unsigned char* dob = (unsigned char*)A.out;
    bf16_t* Win_t = (bf16_t*)(ws + WS_WIN); bf16_t* Wuq_t = (bf16_t*)(ws + WS_WUQ); bf16_t* Wukv_t = (bf16_t*)(ws + WS_WUKV);
    bf16_t* Wpm_t = (bf16_t*)(ws + WS_WPM); bf16_t* Wpd_t = (bf16_t*)(ws + WS_WPD); bf16_t* Wout_t = (bf16_t*)(ws + WS_WOUT);
    float* cosm = (float*)(ws + WS_COSM); float* sinm = (float*)(ws + WS_SINM); float* cosd = (float*)(ws + WS_COSD); float* sind = (float*)(ws + WS_SIND);
    bf16_t* QKVD = (bf16_t*)(ws + WS_QKVD); bf16_t* ZM = (bf16_t*)(ws + WS_ZM); bf16_t* ZD = (bf16_t*)(ws + WS_ZD); bf16_t* XN = (bf16_t*)(ws + WS_XN);
    bf16_t* CQN = (bf16_t*)(ws + WS_CQN); bf16_t* CKVN = (bf16_t*)(ws + WS_CKVN); bf16_t* KR = (bf16_t*)(ws + WS_KR); float* LSE = (float*)(ws + WS_LSE);
    bf16_t* GMD = (bf16_t*)(dob); float* SSQ_Q = (float*)(ws + 65536); float* SSQ_KV = (float*)(ws + 65536 + 131072); bf16_t* MRG = (bf16_t*)(ws + WS_MRG); bf16_t* Y = (bf16_t*)(ws + WS_Y);
    bf16_t* CL = (bf16_t*)(dob + DO_CL); bf16_t* Vb = (bf16_t*)(ws + WS_CQN);     bf16_t* Qb = (bf16_t*)(dob + DO_Q); bf16_t* KN = (bf16_t*)(dob + DO_KN);
    const int lo = A.ph_lo, hi = A.ph_hi;
    volatile LAS unsigned* MISC = (volatile LAS unsigned*)(lds + 131072 + 320);
    if (tid < 32) MISC[tid] = 0u;
    __syncthreads();
    XcdBarrier bar = xcd_barrier_post((unsigned*)(ws + 4096), MISC + 8);
#define IN(k) (lo <= (k) && (k) < hi)
#if N_LAUNCH_MODE == 1
#define SEAM(k) do { if (IN(k) && IN((k) + 1)) { if (lo < 0) grid.sync(); else xcd_barrier(bar); } } while (0)
#else
#define SEAM(k) do { } while (0)
#endif

    if (IN(0)) {
        LAS float* scr = (LAS float*)(lds + wave * 16384);
        constexpr int I_IN = 16 * (N_ALL / 32), I_UQ = 6 * 24, I_UKV = 4 * 32, I_PM = 8 * 32, I_PD = 8 * 32, I_OUT = 16 * 32;
        constexpr int NITEMS = I_IN + I_UQ + I_UKV + I_PM + I_PD + I_OUT;
        for (int it = gw; it < NITEMS; it += NGW) {
            int r = it;
            if (r < I_IN) { const int nblk = N_ALL / 32, kb = r / nblk, nb = r % nblk, n0 = nb * 32;
                const int sn0 = n0 < 5632 ? n0 + 672 : n0 < 6304 ? n0 - 5632 : n0 < 6400 ? -1 : n0 - 96;
                transpose_item(A.w_in, 1024, 8352, Win_t, kb * 64, sn0, n0, scr, lane); continue; } r -= I_IN;
            if (r < I_UQ) { const int kb = r / 24, nb = r % 24; transpose_item(A.w_uq, 384, 768, Wuq_t, kb * 64, nb * 32, nb * 32, scr, lane, A.q_g); continue; } r -= I_UQ;
            if (r < I_UKV) { const int kb = r / 32, nb = r % 32, n0 = nb * 32; const int hh = (n0 & 511) >> 6, sn0 = hh * 128 + (n0 >= 512 ? 64 : 0) + (n0 & 63);
                transpose_item(A.w_ukv, 256, 1024, Wukv_t, kb * 64, sn0, n0, scr, lane, A.kv_g); continue; } r -= I_UKV;
            if (r < I_PM) { const int kb = r / 32, nb = r % 32; transpose_item(A.w_pm, 512, 1024, Wpm_t, kb * 64, nb * 32, nb * 32, scr, lane); continue; } r -= I_PM;
            if (r < I_PD) { const int kb = r / 32, nb = r % 32; transpose_item(A.w_pd, 512, 1024, Wpd_t, kb * 64, nb * 32, nb * 32, scr, lane); continue; } r -= I_PD;
            { const int kb = r / 32, nb = r % 32; transpose_item(A.w_out, 1024, 1024, Wout_t, kb * 64, nb * 32, nb * 32, scr, lane); }
        }
        for (int m0 = gw * 4; m0 < T; m0 += NGW * 4) {
            f32x4 v[4][4]; float s2[4];
#pragma unroll
            for (int r = 0; r < 4; ++r) { const f32x4* xr = (const f32x4*)(A.x + (size_t)(m0 + r) * DM) + lane;
#pragma unroll
                for (int j = 0; j < 4; ++j) v[r][j] = __builtin_nontemporal_load(xr + 64 * j); }
            f32x4 gq[4];
#pragma unroll
            for (int j = 0; j < 4; ++j) gq[j] = ((const f32x4*)A.pre_g)[lane + 64 * j];
#pragma unroll
            for (int r = 0; r < 4; ++r) { float a = 0.f;
#pragma unroll
                for (int j = 0; j < 4; ++j) a += (v[r][j].x * v[r][j].x + v[r][j].y * v[r][j].y) + (v[r][j].z * v[r][j].z + v[r][j].w * v[r][j].w);
                s2[r] = a; }
#pragma unroll
            for (int o = 1; o < 64; o <<= 1) {
#pragma unroll
                for (int r = 0; r < 4; ++r) s2[r] += __shfl_xor(s2[r], o); }
#pragma unroll
            for (int r = 0; r < 4; ++r) { const float rstd = 1.0f / sqrtf(s2[r] * (1.f / DM) + EPS); v2u* o8 = (v2u*)(XN + (size_t)(m0 + r) * DM) + lane;
#pragma unroll
                for (int j = 0; j < 4; ++j) { v2u o; o.x = pk2(v[r][j].x * rstd * gq[j].x, v[r][j].y * rstd * gq[j].y); o.y = pk2(v[r][j].z * rstd * gq[j].z, v[r][j].w * rstd * gq[j].w); o8[64 * j] = o; } }
        }
        for (int e = bx * 512 + tid; e < T * 24; e += G * 512) {
            const int t = e / 24, i = e % 24; const float p = (float)A.pos[t];
            if (i < 16) { const float inv = powf(500000.0f, -(float)(2 * i) / 32.0f); float c, s; sincos_rev(p * inv, c, s); cosm[t * 16 + i] = c; sinm[t * 16 + i] = s; }
            else { const int k = i - 16; const float inv = powf(500000.0f, -(float)(2 * k) / 16.0f); float c, s; sincos_rev(p * inv, c, s); cosd[t * 8 + k] = c; sind[t * 8 + k] = s; }
        }
    }
    SEAM(0);
    if (IN(1)) {
        pg8::Gemm g{XN, Win_t, T, N_IN1, DM}; pg8::StaticOrder S; S.init(T, N_IN1, G, bx);
        pg8::EpiIn E{QKVD, ZM, ZD, CL, SSQ_Q, SSQ_KV};
        pg8::gemm_phase<pg8::EpiIn, pg8::StaticOrder, false, true>(lds, g, S, E);
    }
    SEAM(1);
    if (IN(3)) {
        for (int m = bx * 512 + tid; m < T * 16; m += G * 512) { const int t = m >> 4, i = m & 15; const bf16_t* cl = CL + (size_t)t * 768;
            const float x1 = att::bf2f(cl[640 + i]), x2 = att::bf2f(cl[656 + i]), c = cosm[(size_t)t * 16 + i], sn_ = sinm[(size_t)t * 16 + i];
            KR[(size_t)t * 32 + i] = (bf16_t)f2bf_u(x1 * c - x2 * sn_); KR[(size_t)t * 32 + 16 + i] = (bf16_t)f2bf_u(x2 * c + x1 * sn_); }
        { pg8::Gemm g{CL, Wuq_t, T, 768, 384, 768}; pg8::StaticOrder S; S.init(T, 768, G, bx); pg8::EpiScaleStore E{Qb, 768, 1 << 20, Qb, 768, SSQ_Q, 1.0f / 384.0f};
          pg8::gemm_phase<pg8::EpiScaleStore, pg8::StaticOrder, true, true>(lds, g, S, E); }
        { pg8::Gemm g{CL + 384, Wukv_t, T, 1024, 256, 768}; pg8::StaticOrder S; S.init(T, 1024, G, bx); pg8::EpiScaleStore E{KN, 512, 2, Vb, 512, SSQ_KV, 1.0f / 256.0f};
          pg8::gemm_phase<pg8::EpiScaleStore, pg8::StaticOrder, true, true>(lds, g, S, E); }
    }
    SEAM(3);
    if (IN(4)) {
        if (wave >= 4) __builtin_amdgcn_s_setprio(1);
#if !DEBUG_NAIVE_MLA
        for (int rd = 0; ; ++rd) {
            const int it = rd * G + ((rd & 1) ? (G - 1 - bx) : bx);
            if (rd * G >= 1024) break;
            if (it >= 1024) continue;
            const int qb = 15 - (it >> 6), bh = it & 63, b = bh >> 3, h = bh & 7;
            att::UnitDesc d;
            d.Q = Qb + (size_t)b * SEQ * 768 + h * 96; d.q_rs = 768; d.K = KN + (size_t)b * SEQ * 512 + h * 64; d.k_rs = 512; d.K2 = KR + (size_t)b * SEQ * 32; d.k2_rs = 32;
            d.V = Vb + (size_t)b * SEQ * 512 + h * 64; d.v_rs = 512; d.cs = cosm + (size_t)b * SEQ * 16; d.sn = sinm + (size_t)b * SEQ * 16;
            d.O = ZM + (size_t)b * SEQ * 512 + h * 64; d.o_rs = 512; d.lse = nullptr; d.lse_rs = 0; d.q0 = qb * 256; d.W = 1 << 30; d.c2 = 0.10206207261596577f * 1.4426950408889634f;
            att::mla_unit(lds, d);
        }
#endif
#if !DEBUG_NAIVE_DIL
        const int vcu = (G % 8 == 0) ? (bx % 8) * (G / 8) + bx / 8 : bx;
        for (int it = vcu; it < 1536; it += G) {
            const int bhp = it / 48, rem = it % 48, g = rem >> 4, idx = rem & 15, b = bhp >> 2, hp = bhp & 3;
            const int dil = g == 0 ? 1 : g == 1 ? 4 : 16, nqb = 16 / dil, rs = idx / nqb, qb = idx % nqb;
            att::Dil2Desc d;
            bf16_t* base = QKVD + ((size_t)b * SEQ + rs) * 4608 + g * 512 + hp * 128;
            d.Q = base; d.rs = (long)dil * 4608; d.O = base;
            d.lse = LSE + (size_t)g * T * 8 + ((size_t)b * SEQ + rs) * 8 + hp * 2; d.lse_rs = (long)dil * 8; d.q0 = qb * 256;
            d.cs = cosd + ((size_t)b * SEQ + rs) * 8; d.sn = sind + ((size_t)b * SEQ + rs) * 8; d.dil = dil;
            att::dil_unit3(lds, d);
        }
#endif
    }
    if (IN(4)) __builtin_amdgcn_s_setprio(0);
    SEAM(4);
    if (IN(5)) {
        const int hh = lane >> 3;
        for (int m0 = gw * 4; m0 < T; m0 += NGW * 4) {
            float l0[4], l1[4], l2[4]; v4u x0[4], x1[4], x2[4], zz[4];
#pragma unroll
            for (int r = 0; r < 4; ++r) { const size_t m = (size_t)(m0 + r);
                l0[r] = LSE[m * 8 + hh]; l1[r] = LSE[(size_t)T * 8 + m * 8 + hh]; l2[r] = LSE[(size_t)2 * T * 8 + m * 8 + hh];
                const bf16_t* o = QKVD + m * 4608 + lane * 8; x0[r] = __builtin_nontemporal_load((const v4u*)o); x1[r] = __builtin_nontemporal_load((const v4u*)(o + 512)); x2[r] = __builtin_nontemporal_load((const v4u*)(o + 1024));
                zz[r] = *(const v4u*)(ZD + m * 512 + lane * 8); }
#pragma unroll
            for (int r = 0; r < 4; ++r) {
                const float mx = fmaxf(l0[r], fmaxf(l1[r], l2[r])); float a0 = __expf(l0[r] - mx), a1 = __expf(l1[r] - mx), a2 = __expf(l2[r] - mx); const float inv = 1.0f / (a0 + a1 + a2); a0 *= inv; a1 *= inv; a2 *= inv;
                const v4u z = zz[r]; v4u rr;
#define CMB(c) rr.c = pk2((a0 * bflo(x0[r].c) + a1 * bflo(x1[r].c) + a2 * bflo(x2[r].c)) * bflo(z.c), (a0 * bfhi(x0[r].c) + a1 * bfhi(x1[r].c) + a2 * bfhi(x2[r].c)) * bfhi(z.c))
                CMB(x); CMB(y); CMB(z); CMB(w);
#undef CMB
                *(v4u*)(ZD + (size_t)(m0 + r) * 512 + lane * 8) = rr; }
        }
    }
    __syncthreads();
    if (IN(6)) {
        pg8::Gemm g{XN, Win_t + (size_t)N_IN1 * DM, T, 2048, DM}; pg8::StaticOrder S; S.init(T, 2048, G, bx); pg8::EpiSig E{GMD, 2048};
        pg8::gemm_phase<pg8::EpiSig, pg8::StaticOrder, false, true>(lds, g, S, E);
    }
    SEAM(6);
    if (IN(7)) {
        pg8::StaticOrder S; S.init(T, 1024, G, bx);
        { pg8::Gemm g{ZM, Wpm_t, T, 1024, 512}; pg8::EpiGate<false> E{MRG, 1024, GMD, 2048, 0};
          pg8::gemm_phase<pg8::EpiGate<false>, pg8::StaticOrder, true, true>(lds, g, S, E); }
        { pg8::Gemm g{ZD, Wpd_t, T, 1024, 512}; pg8::EpiGate<true> E{MRG, 1024, GMD, 2048, 1024};
          pg8::gemm_phase<pg8::EpiGate<true>, pg8::StaticOrder, true, true>(lds, g, S, E); }
    }
    SEAM(7);
    if (IN(8)) {
        pg8::Gemm g{MRG, Wout_t, T, 1024, DM}; pg8::StaticOrder S; S.init(T, 1024, G, bx); pg8::EpiStore E{Y, 1024, 1 << 20, Y, 1024};
        pg8::gemm_phase<pg8::EpiStore, pg8::StaticOrder, true, true>(lds, g, S, E);
    }
    SEAM(8);
    if (IN(9)) {
        float dbgC = 0.f, dbgB = 0.f;
        for (int m0 = gw * 2; m0 < T; m0 += NGW * 2) {
            v4u w[2][2]; f32x4 xa[2][2], xb[2][2]; float s2[2];
#pragma unroll
            for (int r = 0; r < 2; ++r) { const v4u* yr = (const v4u*)(Y + (size_t)(m0 + r) * DM);
#pragma unroll
                for (int j = 0; j < 2; ++j) { w[r][j] = yr[lane + 64 * j]; const f32x4* xp = (const f32x4*)(A.x + (size_t)(m0 + r) * DM + (lane + 64 * j) * 8); xa[r][j] = __builtin_nontemporal_load(xp); xb[r][j] = __builtin_nontemporal_load(xp + 1); } }
#pragma unroll
            for (int r = 0; r < 2; ++r) { float a = 0.f;
#pragma unroll
                for (int j = 0; j < 2; ++j) a += bflo(w[r][j].x) * bflo(w[r][j].x) + bfhi(w[r][j].x) * bfhi(w[r][j].x) + bflo(w[r][j].y) * bflo(w[r][j].y) + bfhi(w[r][j].y) * bfhi(w[r][j].y)
                    + bflo(w[r][j].z) * bflo(w[r][j].z) + bfhi(w[r][j].z) * bfhi(w[r][j].z) + bflo(w[r][j].w) * bflo(w[r][j].w) + bfhi(w[r][j].w) * bfhi(w[r][j].w);
                s2[r] = a; }
#pragma unroll
            for (int o = 1; o < 64; o <<= 1) { s2[0] += __shfl_xor(s2[0], o); s2[1] += __shfl_xor(s2[1], o); }
#pragma unroll
            for (int r = 0; r < 2; ++r) { const float rstd = 1.0f / sqrtf(s2[r] * (1.f / DM) + EPS);
#pragma unroll
                for (int j = 0; j < 2; ++j) { const int c = (lane + 64 * j) * 8; const f32x4* gp = (const f32x4*)(A.post_g + c); f32x4* op = (f32x4*)(A.out + (size_t)(m0 + r) * DM + c);
                    const f32x4 ga = gp[0], gb = gp[1]; f32x4 oa, ob; const v4u ww = w[r][j];
                    oa.x = xa[r][j].x + bflo(ww.x) * rstd * ga.x; oa.y = xa[r][j].y + bfhi(ww.x) * rstd * ga.y; oa.z = xa[r][j].z + bflo(ww.y) * rstd * ga.z; oa.w = xa[r][j].w + bfhi(ww.y) * rstd * ga.w;
                    ob.x = xb[r][j].x + bflo(ww.z) * rstd * gb.x; ob.y = xb[r][j].y + bfhi(ww.z) * rstd * gb.y; ob.z = xb[r][j].z + bflo(ww.w) * rstd * gb.z; ob.w = xb[r][j].w + bfhi(ww.w) * rstd * gb.w;
                    __builtin_nontemporal_store(oa, op); __builtin_nontemporal_store(ob, op + 1); } }
        }
    }
#undef IN
#undef SEAM
}


#if DEBUG_NAIVE_MLA
__global__ void __launch_bounds__(256) naive_mla(Args A) {
    unsigned char* ws = A.ws; unsigned char* dob = (unsigned char*)A.out;
    const float* cosm = (const float*)(ws + WS_COSM); const float* sinm = (const float*)(ws + WS_SINM);
    bf16_t* ZM = (bf16_t*)(ws + WS_ZM); const bf16_t* KR = (const bf16_t*)(ws + WS_KR);
    const bf16_t* Vb = (const bf16_t*)(dob + DO_V); const bf16_t* Qb = (const bf16_t*)(dob + DO_Q); const bf16_t* KN = (const bf16_t*)(dob + DO_KN);
    const int gid = blockIdx.x * 256 + threadIdx.x;
    const int tq = gid & 4095, h = (gid >> 12) & 7, b = gid >> 15;
    const size_t row = (size_t)b * SEQ + tq;
    float q[96];
#pragma unroll
    for (int d = 0; d < 96; ++d) q[d] = att::bf2f(Qb[row * 768 + h * 96 + d]);
#pragma unroll
    for (int i = 0; i < 16; ++i) { const float c = cosm[row * 16 + i], s = sinm[row * 16 + i], x1 = q[64 + i], x2 = q[80 + i];
        q[64 + i] = att::bf2f(att::f2bf(x1 * c - x2 * s)); q[80 + i] = att::bf2f(att::f2bf(x2 * c + x1 * s)); }
    float o[64];
#pragma unroll
    for (int d = 0; d < 64; ++d) o[d] = 0.f;
    float m = -INFINITY, l = 0.f;
    const int kmax = (tq | 63);
    for (int k = 0; k <= kmax; ++k) {
        const size_t kr = (size_t)b * SEQ + k; float s = 0.f;
#pragma unroll
        for (int d = 0; d < 64; ++d) s += q[d] * att::bf2f(KN[kr * 512 + h * 64 + d]);
#pragma unroll
        for (int d = 0; d < 32; ++d) s += q[64 + d] * att::bf2f(KR[kr * 32 + d]);
        s *= 0.10206207261596577f;
        if (k <= tq) {
            const float mn = fmaxf(m, s), f = __expf(m - mn), p = __expf(s - mn);
            l = l * f + p;
#pragma unroll
            for (int d = 0; d < 64; ++d) o[d] = o[d] * f + p * att::bf2f(Vb[kr * 512 + h * 64 + d]);
            m = mn;
        }
    }
    const float inv = 1.f / l;
#pragma unroll
    for (int d = 0; d < 64; ++d) { bf16_t* op = ZM + row * 512 + h * 64 + d; *op = att::f2bf(o[d] * inv * att::bf2f(*op)); }
}
#endif
#if DEBUG_NAIVE_DIL
__global__ void __launch_bounds__(256) naive_dil(Args A) {
    unsigned char* ws = A.ws;
    bf16_t* QKVD = (bf16_t*)(ws + WS_QKVD); float* LSE = (float*)(ws + WS_LSE);
    const int gid = blockIdx.x * 256 + threadIdx.x;
    const int t = gid & 4095, h = (gid >> 12) & 7, g = (gid >> 15) % 3, b = gid / (3 * 32768);
    const int dil = g == 0 ? 1 : g == 1 ? 4 : 16;
    const size_t row = (size_t)b * SEQ + t;
    bf16_t* qp = QKVD + row * 4608 + g * 512 + h * 64;
    float q[64], o[64];
#pragma unroll
    for (int d = 0; d < 64; ++d) { q[d] = att::bf2f(qp[d]); o[d] = 0.f; }
    float m = -INFINITY, l = 0.f;
    const int mi = t / dil;
    for (int i = 0; i <= 128; ++i) {
        if (mi - i < 0) break;
        const size_t kr = row - (size_t)i * dil; const bf16_t* kp = QKVD + kr * 4608 + 1536 + g * 512 + h * 64; float s = 0.f;
#pragma unroll
        for (int d = 0; d < 64; ++d) s += q[d] * att::bf2f(kp[d]);
        s *= 0.125f;
        const float mn = fmaxf(m, s), f = __expf(m - mn), p = __expf(s - mn);
        l = l * f + p;
#pragma unroll
        for (int d = 0; d < 64; ++d) o[d] = o[d] * f + p * att::bf2f(kp[1536 + d]);
        m = mn;
    }
    const float inv = 1.f / l;
    __syncthreads();
#pragma unroll
    for (int d = 0; d < 64; ++d) qp[d] = att::f2bf(o[d] * inv);
    LSE[(size_t)g * T * 8 + row * 8 + h] = m + __logf(l);
}
#endif

#if DEBUG_CHECK
template <int MODE> __global__ void __launch_bounds__(256) check_kernel(Args A) {
    unsigned char* ws = A.ws; unsigned char* dob = (unsigned char*)A.out; unsigned* flags = (unsigned*)ws;
    const bf16_t* QKVD = (const bf16_t*)(ws + WS_QKVD); const bf16_t* ZM = (const bf16_t*)(ws + WS_ZM); const bf16_t* ZD = (const bf16_t*)(ws + WS_ZD); const bf16_t* XN = (const bf16_t*)(ws + WS_XN);
    const bf16_t* CQN = (const bf16_t*)(ws + WS_CQN); const bf16_t* CKVN = (const bf16_t*)(ws + WS_CKVN);
    const bf16_t* MRG = (const bf16_t*)(ws + WS_MRG); const bf16_t* Y = (const bf16_t*)(ws + WS_Y);
    const bf16_t* CL = (const bf16_t*)(dob + DO_CL); const bf16_t* Vb = (const bf16_t*)(dob + DO_V); const bf16_t* Qb = (const bf16_t*)(dob + DO_Q); const bf16_t* KN = (const bf16_t*)(dob + DO_KN);
    const float* cosm = (const float*)(ws + WS_COSM); const float* sinm = (const float*)(ws + WS_SINM); const float* cosd = (const float*)(ws + WS_COSD); const float* sind = (const float*)(ws + WS_SIND);
    const unsigned idx0 = blockIdx.x * 256 + threadIdx.x;
    unsigned hsh = idx0 * 2654435761u; hsh ^= hsh >> 15; hsh *= 2246822519u; hsh ^= hsh >> 13; hsh *= 3266489917u; hsh ^= hsh >> 16;
    const unsigned idx = hsh >> 7;
    const size_t row = (hsh * 2654435761u >> 9) % (unsigned)T;
    float got = 0.f, ref = 0.f; unsigned bit = 0;
    if (MODE == 1) { const int n = (idx * 40503u + 17u) % 6304u; float acc = 0.f;
        for (int k = 0; k < 1024; ++k) acc += att::bf2f(XN[row * 1024 + k]) * A.w_in[(size_t)k * 8352 + n];
        if (n < 672) { got = att::bf2f(CL[row * 768 + n]); ref = acc; } else if (n < 5280) { got = att::bf2f(QKVD[row * 4608 + n - 672]); ref = acc; }
        else if (n < 5792) { got = att::bf2f(ZM[row * 512 + n - 5280]); ref = pg8::silu_f(acc); } else { got = att::bf2f(ZD[row * 512 + n - 5792]); ref = pg8::silu_f(acc); }
        bit = 1u; }
    if (MODE == 2) { const int n = (idx * 40503u + 17u) % 1792u; float acc = 0.f;
        if (n < 768) { for (int k = 0; k < 384; ++k) acc += att::bf2f(CQN[row * 384 + k]) * A.w_uq[(size_t)k * 768 + n]; got = att::bf2f(Qb[row * 768 + n]); }
        else { const int c = n - 768, hh = c >> 7, w = c & 127; for (int k = 0; k < 256; ++k) acc += att::bf2f(CKVN[row * 256 + k]) * A.w_ukv[(size_t)k * 1024 + c];
            got = w < 64 ? att::bf2f(KN[row * 512 + hh * 64 + w]) : att::bf2f(Vb[row * 512 + hh * 64 + w - 64]); }
        ref = acc; bit = 2u; }
    if (MODE == 3) { const int n = (idx * 40503u + 17u) % 1024u; float g1 = 0.f, g2 = 0.f, y1 = 0.f, y2 = 0.f;
        for (int k = 0; k < 1024; ++k) { const float xv = att::bf2f(XN[row * 1024 + k]); g1 += xv * A.w_in[(size_t)k * 8352 + 6304 + n]; g2 += xv * A.w_in[(size_t)k * 8352 + 7328 + n]; }
        for (int k = 0; k < 512; ++k) { y1 += att::bf2f(ZM[row * 512 + k]) * A.w_pm[(size_t)k * 1024 + n]; y2 += att::bf2f(ZD[row * 512 + k]) * A.w_pd[(size_t)k * 1024 + n]; }
        ref = pg8::sigm_f(g1) * y1 + pg8::sigm_f(g2) * y2; got = att::bf2f(MRG[row * 1024 + n]); bit = 4u; }
    if (MODE == 4) { const int n = (idx * 40503u + 17u) % 1024u; float acc = 0.f;
        for (int k = 0; k < 1024; ++k) acc += att::bf2f(MRG[row * 1024 + k]) * A.w_out[(size_t)k * 1024 + n];
        ref = acc; got = att::bf2f(Y[row * 1024 + n]); bit = 8u; }
    if (MODE == 6) { const int n = (idx * 40503u + 17u) % 2048u; float g1 = 0.f; const bf16_t* GMD = (const bf16_t*)(dob);
        for (int k = 0; k < 1024; ++k) g1 += att::bf2f(XN[row * 1024 + k]) * A.w_in[(size_t)k * 8352 + 6304 + n];
        ref = pg8::sigm_f(g1); got = att::bf2f(GMD[row * 2048 + n]); bit = 1u; }
    if (MODE == 7) { const int n = (idx * 40503u + 17u) % 1024u; float y1 = 0.f, y2 = 0.f; const bf16_t* GMD = (const bf16_t*)(dob);
        for (int k = 0; k < 512; ++k) { y1 += att::bf2f(ZM[row * 512 + k]) * A.w_pm[(size_t)k * 1024 + n]; y2 += att::bf2f(ZD[row * 512 + k]) * A.w_pd[(size_t)k * 1024 + n]; }
        ref = att::bf2f(GMD[row * 2048 + n]) * y1 + att::bf2f(GMD[row * 2048 + 1024 + n]) * y2; got = att::bf2f(MRG[row * 1024 + n]); bit = 2u; }
    if (MODE == 8) { const int n = (idx * 40503u + 17u) % 2048u, k = ((hsh >> 3) * 7919u + 3u) % 1021u; const bf16_t* Win_t = (const bf16_t*)(ws + WS_WIN);
        ref = A.w_in[(size_t)k * 8352 + 6304 + n]; got = att::bf2f(Win_t[(size_t)(6400 + n) * 1024 + k]); bit = 2u; }
    if (MODE == 9) { const int n = (idx * 40503u + 17u) % 5632u, k = ((hsh >> 3) * 7919u + 3u) % 1021u; const bf16_t* Win_t = (const bf16_t*)(ws + WS_WIN);
        ref = A.w_in[(size_t)k * 8352 + 672 + n]; got = att::bf2f(Win_t[(size_t)n * 1024 + k]); bit = 8u; }
    if (MODE == 5) { const int i = idx % 24u; const float p = (float)A.pos[row];
        if (i < 16) { const float inv = powf(500000.0f, -(float)(2 * i) / 32.0f); const float a = p * inv; ref = (idx & 32u) ? cosf(a) : sinf(a); got = (idx & 32u) ? cosm[row * 16 + i] : sinm[row * 16 + i]; }
        else { const int k = i - 16; const float inv = powf(500000.0f, -(float)(2 * k) / 16.0f); const float a = p * inv; ref = (idx & 32u) ? cosf(a) : sinf(a); got = (idx & 32u) ? cosd[row * 8 + k] : sind[row * 8 + k]; }
        bit = 16u; }
    const float err = fabsf(got - ref), tol = (MODE == 5) ? 2e-3f : (MODE == 8 || MODE == 9) ? 2e-4f + 0.01f * fabsf(ref) : 0.04f + 0.03f * fabsf(ref);
    if (!(err <= tol)) { atomicOr(flags, bit); if (MODE == 6) { const unsigned nn = ((idx * 40503u + 17u) % 2048u) & 255u, rr = (unsigned)row & 255u; atomicMax(flags + 1, nn + 1u); atomicMax(flags + 2, 256u - nn); atomicMax(flags + 3, rr + 1u); atomicMax(flags + 4, 256u - rr); } }
}
#endif

#if DEBUG_NAIVE_GEMM
template <int MODE> __global__ void __launch_bounds__(256) naive_gemm(Args A_, const bf16_t* Am, int K, const float* W, int ldw, int woff, int N) {
    __shared__ float As[16][65]; __shared__ float Bs[16][65];
    unsigned char* ws = A_.ws; unsigned char* dob = (unsigned char*)A_.out;
    bf16_t* QKVD = (bf16_t*)(ws + WS_QKVD); bf16_t* ZM = (bf16_t*)(ws + WS_ZM); bf16_t* ZD = (bf16_t*)(ws + WS_ZD);
    bf16_t* GMD = (bf16_t*)(dob); bf16_t* MRG = (bf16_t*)(ws + WS_MRG); bf16_t* Y = (bf16_t*)(ws + WS_Y);
    bf16_t* CL = (bf16_t*)(dob + DO_CL); bf16_t* Vb = (bf16_t*)(dob + DO_V); bf16_t* Qb = (bf16_t*)(dob + DO_Q); bf16_t* KN = (bf16_t*)(dob + DO_KN);
    const int tid = threadIdx.x, tx = tid & 15, ty = tid >> 4;
    const int m0 = blockIdx.y * 64, n0 = blockIdx.x * 64;
    float acc[4][4];
#pragma unroll
    for (int i = 0; i < 4; ++i)
#pragma unroll
        for (int j = 0; j < 4; ++j) acc[i][j] = 0.f;
    for (int k0 = 0; k0 < K; k0 += 16) {
#pragma unroll
        for (int e = 0; e < 4; ++e) { const int idx = tid + 256 * e; const int r = idx >> 4, kk = idx & 15; As[kk][r] = att::bf2f(Am[(size_t)(m0 + r) * K + k0 + kk]); }
#pragma unroll
        for (int e = 0; e < 4; ++e) { const int idx = tid + 256 * e; const int kk = idx >> 6, c = idx & 63; const int n = n0 + c; Bs[kk][c] = n < N ? W[(size_t)(k0 + kk) * ldw + woff + n] : 0.f; }
        __syncthreads();
#pragma unroll
        for (int kk = 0; kk < 16; ++kk) { float a[4], b[4];
#pragma unroll
            for (int i = 0; i < 4; ++i) { a[i] = As[kk][ty * 4 + i]; b[i] = Bs[kk][tx * 4 + i]; }
#pragma unroll
            for (int i = 0; i < 4; ++i)
#pragma unroll
                for (int j = 0; j < 4; ++j) acc[i][j] += a[i] * b[j]; }
        __syncthreads();
    }
#pragma unroll
    for (int i = 0; i < 4; ++i)
#pragma unroll
        for (int j = 0; j < 4; ++j) {
            const size_t row = m0 + ty * 4 + i; const int n = n0 + tx * 4 + j; if (n >= N) continue; const float v = acc[i][j];
            if (MODE == 0) { if (n < 672) CL[row * 768 + n] = att::f2bf(v); else if (n < 5280) QKVD[row * 4608 + n - 672] = att::f2bf(v);
                else if (n < 5792) ZM[row * 512 + n - 5280] = att::f2bf(pg8::silu_f(v)); else ZD[row * 512 + n - 5792] = att::f2bf(pg8::silu_f(v)); }
            if (MODE == 1) Qb[row * 768 + n] = att::f2bf(v);
            if (MODE == 2) { const int hh = n >> 7, w = n & 127; if (w < 64) KN[row * 512 + hh * 64 + w] = att::f2bf(v); else Vb[row * 512 + hh * 64 + w - 64] = att::f2bf(v); }
            if (MODE == 3) GMD[row * 2048 + n] = att::f2bf(pg8::sigm_f(v));
            if (MODE == 4) MRG[row * 1024 + n] = att::f2bf(v * att::bf2f(GMD[row * 2048 + n]));
            if (MODE == 5) MRG[row * 1024 + n] = att::f2bf(att::bf2f(MRG[row * 1024 + n]) + v * att::bf2f(GMD[row * 2048 + 1024 + n]));
            if (MODE == 6) Y[row * 1024 + n] = att::f2bf(v);
        }
}
#endif

extern "C" void kernel_launch(void* const* d_in, const int* in_sizes, int n_in, void* d_out, int out_size, void* d_ws, size_t ws_size, hipStream_t stream) {
    static int grid = 0;
    if (grid == 0) {
        if (n_in != 12 || out_size != T * DM || ws_size < WS_END) { fprintf(stderr, "kernel_launch: unexpected problem shape / workspace (%d inputs, out %d, ws %zu)\n", n_in, out_size, ws_size); grid = -1; return; }
        int dev = 0, cus = 0, per_cu = 0;
        (void)hipGetDevice(&dev); (void)hipDeviceGetAttribute(&cus, hipDeviceAttributeMultiprocessorCount, dev);
        (void)hipFuncSetAttribute((const void*)fwd_kernel, hipFuncAttributeMaxDynamicSharedMemorySize, LDS_BYTES);
        (void)hipOccupancyMaxActiveBlocksPerMultiprocessor(&per_cu, (const void*)fwd_kernel, 512, LDS_BYTES);
        (void)hipGetLastError();
        if (per_cu < 1) per_cu = 1;
        grid = cus * 1;
    }
    if (grid < 0) return;
    (void)hipMemsetAsync(d_ws, 0, 65536 + 2 * 131072, stream);
#if DEBUG_CHECK
    (void)hipMemsetAsync(d_ws, 0, 256, stream);
#endif
    Args a{};
    a.x = (const float*)d_in[0]; a.pos = (const int*)d_in[1]; a.pre_g = (const float*)d_in[2]; a.w_in = (const float*)d_in[3]; a.q_g = (const float*)d_in[4]; a.w_uq = (const float*)d_in[5];
    a.kv_g = (const float*)d_in[6]; a.w_ukv = (const float*)d_in[7]; a.w_pm = (const float*)d_in[8]; a.w_pd = (const float*)d_in[9]; a.w_out = (const float*)d_in[10]; a.post_g = (const float*)d_in[11];
    a.out = (float*)d_out; a.ws = (unsigned char*)d_ws;
    if (N_LAUNCH_MODE == 1) {
        a.ph_lo = 0; a.ph_hi = 10; void* args[] = {&a};
        hipError_t e = hipLaunchCooperativeKernel((const void*)fwd_kernel, dim3(grid), dim3(512), args, LDS_BYTES, stream);
        if (e != hipSuccess) fprintf(stderr, "cooperative launch failed: %s (grid %d)\n", hipGetErrorString(e), grid);
    } else {
        for (int p = 0; p < 10; ++p) { a.ph_lo = p; a.ph_hi = p + 1;
#if DEBUG_NAIVE_GEMM
            bf16_t* XN_ = (bf16_t*)((unsigned char*)d_ws + WS_XN); bf16_t* CQN_ = (bf16_t*)((unsigned char*)d_ws + WS_CQN); bf16_t* CKVN_ = (bf16_t*)((unsigned char*)d_ws + WS_CKVN);
            bf16_t* ZM_ = (bf16_t*)((unsigned char*)d_ws + WS_ZM); bf16_t* ZD_ = (bf16_t*)((unsigned char*)d_ws + WS_ZD); bf16_t* MRG_ = (bf16_t*)((unsigned char*)d_ws + WS_MRG);
            if (p == 1 && (DEBUG_NAIVE_GEMM & 1)) { hipLaunchKernelGGL(naive_gemm<0>, dim3((6304 + 63) / 64, T / 64), dim3(256), 0, stream, a, XN_, 1024, a.w_in, 8352, 0, 6304); continue; }
            if (p == 3 && (DEBUG_NAIVE_GEMM & 2)) { hipLaunchKernelGGL(naive_gemm<1>, dim3(768 / 64, T / 64), dim3(256), 0, stream, a, CQN_, 384, a.w_uq, 768, 0, 768);
                hipLaunchKernelGGL(naive_gemm<2>, dim3(1024 / 64, T / 64), dim3(256), 0, stream, a, CKVN_, 256, a.w_ukv, 1024, 0, 1024); continue; }
            if (p == 66 && (DEBUG_NAIVE_GEMM & 4)) { hipLaunchKernelGGL(naive_gemm<3>, dim3(2048 / 64, T / 64), dim3(256), 0, stream, a, XN_, 1024, a.w_in, 8352, 6304, 2048);
                hipLaunchKernelGGL(naive_gemm<4>, dim3(1024 / 64, T / 64), dim3(256), 0, stream, a, ZM_, 512, a.w_pm, 1024, 0, 1024);
                hipLaunchKernelGGL(naive_gemm<5>, dim3(1024 / 64, T / 64), dim3(256), 0, stream, a, ZD_, 512, a.w_pd, 1024, 0, 1024); continue; }
            if (p == 77 && (DEBUG_NAIVE_GEMM & 8)) { hipLaunchKernelGGL(naive_gemm<6>, dim3(1024 / 64, T / 64), dim3(256), 0, stream, a, MRG_, 1024, a.w_out, 1024, 0, 1024); continue; }
#endif
            hipLaunchKernelGGL(fwd_kernel, dim3(grid), dim3(512), LDS_BYTES, stream, a);
#if DEBUG_CHECK
            if (p == 0) hipLaunchKernelGGL(check_kernel<5>, dim3(32), dim3(256), 0, stream, a);
            if (p == 7) hipLaunchKernelGGL(check_kernel<6>, dim3(64), dim3(256), 0, stream, a);
            if (p == 0) hipLaunchKernelGGL(check_kernel<8>, dim3(64), dim3(256), 0, stream, a);
            if (p == 5) hipLaunchKernelGGL(check_kernel<8>, dim3(64), dim3(256), 0, stream, a);
            if (p == 5) hipLaunchKernelGGL(check_kernel<9>, dim3(64), dim3(256), 0, stream, a);
            if (p == 7) hipLaunchKernelGGL(check_kernel<3>, dim3(32), dim3(256), 0, stream, a);
#endif
#if DEBUG_NAIVE_MLA
            if (p == 4) hipLaunchKernelGGL(naive_mla, dim3(T * 8 / 256), dim3(256), 0, stream, a);
#endif
#if DEBUG_NAIVE_DIL
            if (p == 4) hipLaunchKernelGGL(naive_dil, dim3(T * 24 / 256), dim3(256), 0, stream, a);
#endif
        }
    }
}
```
